# Optimizing an MI355X kernel written in HIP

```python
import math
import jax, jax.numpy as jnp
from jax import lax
import numpy as np

D_MODEL = 1024
BATCH = 1
SEQ = 16384
DEPTH = 4

ATTN_HEADS = 4
HEAD_DIM = 64
V_DIM = 2 * HEAD_DIM
ATTN_WIDTH = ATTN_HEADS * V_DIM
QK_WIDTH = ATTN_HEADS * 2 * HEAD_DIM
POOL_WINDOWS = (2, 4, 8, 16)
POOL_GROUPS = len(POOL_WINDOWS)
POOL_GROUP_DIM = 128
POOL_WIDTH = POOL_GROUPS * POOL_GROUP_DIM
N_BRANCHES = 2
GATE_WIDTH = N_BRANCHES * D_MODEL
IN_COLS = 2 * QK_WIDTH + ATTN_WIDTH + POOL_WIDTH + GATE_WIDTH
D_FF = 4 * D_MODEL
BLOCK_Q = 128
EPS = 1e-6
NEG_BIG = -1e30

kernel_name = "hybrid_diffattn_pool_gated_block"


def rms_norm(x, g):
    xf = x.astype(jnp.float32)
    y = xf * lax.rsqrt(jnp.mean(xf * xf, axis=-1, keepdims=True) + EPS)
    return (y * g.astype(jnp.float32)).astype(x.dtype)


def lambda_init_fn(layer_idx):
    return 0.8 - 0.6 * math.exp(-0.3 * layer_idx)


def diff_attention(q, k, v, lam):
    B, S, H, _, d = q.shape
    nb = S // BLOCK_Q
    qh = q.transpose(0, 2, 3, 1, 4)
    kh = k.transpose(0, 2, 3, 1, 4)
    vh = v.transpose(0, 2, 1, 3)
    qb = qh.reshape(B, H, 2, nb, BLOCK_Q, d).transpose(3, 0, 1, 2, 4, 5)
    k_pos = jnp.arange(S)
    scale = d ** -0.5

    def one_block(args):
        q_blk, start = args
        s = jnp.einsum('bhcqd,bhckd->bhcqk', q_blk, kh).astype(jnp.float32) * scale
        q_pos = start + jnp.arange(BLOCK_Q)
        mask = k_pos[None, :] <= q_pos[:, None]
        s = jnp.where(mask, s, NEG_BIG)
        p = jax.nn.softmax(s, axis=-1)
        w = p[:, :, 0] - lam * p[:, :, 1]
        return jnp.einsum('bhqk,bhke->bhqe', w.astype(vh.dtype), vh)

    starts = jnp.arange(nb) * BLOCK_Q
    out = lax.map(one_block, (qb, starts))
    return out.transpose(1, 0, 3, 2, 4).reshape(B, S, H, 2 * d)


def causal_pool_mixer(xp, pool_w, pool_scale):
    B, S, _ = xp.shape
    xg = xp.reshape(B, S, POOL_GROUPS, POOL_GROUP_DIM)
    xf = xg.astype(jnp.float32)
    c0 = jnp.concatenate([jnp.zeros((B, 1, POOL_GROUPS, POOL_GROUP_DIM), jnp.float32),
                          jnp.cumsum(xf, axis=1)], axis=1)
    upper = c0[:, 1:]
    t1 = jnp.arange(1, S + 1, dtype=jnp.float32)
    outs = []
    for g, w in enumerate(POOL_WINDOWS):
        lower = jnp.concatenate([jnp.zeros((B, w - 1, POOL_GROUP_DIM), jnp.float32),
                                 c0[:, :S - w + 1, g]], axis=1)
        count = jnp.minimum(t1, float(w))[None, :, None]
        outs.append((upper[:, :, g] - lower) / count - xf[:, :, g])
    pooled = jnp.stack(outs, axis=2).astype(xp.dtype)
    mixed = jnp.einsum('bsgc,gcd->bsgd', pooled, pool_w)
    return mixed.reshape(B, S, POOL_WIDTH) * pool_scale


def setup_inputs(seed: int = 0) -> dict:
    key = jax.random.key(seed)
    ks = jax.random.split(key, 20)
    f = jnp.float32
    nrm = lambda k, shape, s: jax.random.normal(k, shape, f) * s
    return {
        "x": jax.random.normal(ks[0], (BATCH, SEQ, D_MODEL), f),
        "norm1_g": 1.0 + nrm(ks[1], (DEPTH, D_MODEL), 0.1),
        "w_in": nrm(ks[2], (DEPTH, D_MODEL, IN_COLS), D_MODEL ** -0.5),
        "b_gate": nrm(ks[3], (DEPTH, GATE_WIDTH), 0.1),
        "q_norm_g": 1.0 + nrm(ks[4], (DEPTH, HEAD_DIM), 0.1),
        "k_norm_g": 1.0 + nrm(ks[5], (DEPTH, HEAD_DIM), 0.1),
        "lam_params": nrm(ks[6], (DEPTH, 4, HEAD_DIM), 0.1),
        "subln_g": 1.0 + nrm(ks[7], (DEPTH, V_DIM), 0.1),
        "pool_w": nrm(ks[8], (DEPTH, POOL_GROUPS, POOL_GROUP_DIM, POOL_GROUP_DIM), POOL_GROUP_DIM ** -0.5),
        "pool_scale": 1.0 + nrm(ks[9], (DEPTH, POOL_WIDTH), 0.1),
        "w_up_attn": nrm(ks[10], (DEPTH, ATTN_WIDTH, D_MODEL), ATTN_WIDTH ** -0.5),
        "w_up_pool": nrm(ks[11], (DEPTH, POOL_WIDTH, D_MODEL), POOL_WIDTH ** -0.5),
        "w_o": nrm(ks[12], (DEPTH, D_MODEL, D_MODEL), D_MODEL ** -0.5),
        "norm2_g": 1.0 + nrm(ks[13], (DEPTH, D_MODEL), 0.1),
        "w_mlp_in": nrm(ks[14], (DEPTH, D_MODEL, D_FF), D_MODEL ** -0.5),
        "w_mlp_out": nrm(ks[15], (DEPTH, D_FF, D_MODEL), D_FF ** -0.5),
    }


def reference(x, norm1_g, w_in, b_gate, q_norm_g, k_norm_g, lam_params, subln_g,
              pool_w, pool_scale, w_up_attn, w_up_pool, w_o, norm2_g, w_mlp_in, w_mlp_out):
    B, S, _ = x.shape
    c_q = QK_WIDTH
    c_k = c_q + QK_WIDTH
    c_v = c_k + ATTN_WIDTH
    c_p = c_v + POOL_WIDTH
    for l in range(DEPTH):
        lam_init = lambda_init_fn(l)
        h = rms_norm(x, norm1_g[l])
        proj = jnp.einsum('bsd,dc->bsc', h, w_in[l])
        q = proj[..., :c_q].reshape(B, S, ATTN_HEADS, 2, HEAD_DIM)
        k = proj[..., c_q:c_k].reshape(B, S, ATTN_HEADS, 2, HEAD_DIM)
        v = proj[..., c_k:c_v].reshape(B, S, ATTN_HEADS, V_DIM)
        xp = proj[..., c_v:c_p]
        gates = jax.nn.sigmoid(proj[..., c_p:] + b_gate[l]).reshape(B, S, N_BRANCHES, D_MODEL)

        q = rms_norm(q, q_norm_g[l])
        k = rms_norm(k, k_norm_g[l])
        lp = lam_params[l].astype(jnp.float32)
        lam = (jnp.exp(jnp.sum(lp[0] * lp[1])) - jnp.exp(jnp.sum(lp[2] * lp[3]))
               + lam_init)
        a = diff_attention(q, k, v, lam)
        a = rms_norm(a, subln_g[l]) * (1.0 - lam_init)
        y_attn = jnp.einsum('bsa,ad->bsd', a.reshape(B, S, ATTN_WIDTH), w_up_attn[l])

        p = causal_pool_mixer(xp, pool_w[l], pool_scale[l])
        y_pool = jnp.einsum('bsp,pd->bsd', p, w_up_pool[l])

        merged = gates[:, :, 0] * y_attn + gates[:, :, 1] * y_pool
        x = x + jnp.einsum('bsd,de->bse', merged, w_o[l])

        h2 = rms_norm(x, norm2_g[l])
        u = jnp.square(jax.nn.relu(jnp.einsum('bsd,df->bsf', h2, w_mlp_in[l])))
        x = x + jnp.einsum('bsf,fd->bsd', u, w_mlp_out[l])
    return x
```

```cpp
#include <hip/hip_runtime.h>
#include <hip/hip_cooperative_groups.h>
#include <cstdio>
#include <cstdint>
#include <cmath>
namespace cg = cooperative_groups;
namespace pg8 {
#define PG8_LAS __attribute__((address_space(3)))
typedef unsigned short bf16_t;
typedef short bf16x8 __attribute__((ext_vector_type(8)));
typedef float f32x4 __attribute__((ext_vector_type(4)));
typedef unsigned u32x4 __attribute__((ext_vector_type(4)));
constexpr int BM = 256, BK = 64, HALF = 128, HTB = HALF * BK * 2  , STAGE_BYTES = 8 * HTB, NXCD = 8, WGM = 8;

__host__ __device__ __forceinline__ int lds_byte(int r, int c) { const int st = (r >> 4) * 2 + (c >> 5), rr = r & 15, cc = c & 31, ob = rr * 64 + cc * 2; return st * 1024 + (ob ^ (((ob >> 9) & 1) << 5)); }
__host__ __device__ __forceinline__ void stage_rc(int b, int& R, int& C) { const int st = b / 1024, sb = b % 1024, swz = sb ^ (((sb >> 9) & 1) << 5); R = (st >> 1) * 16 + swz / 64; C = (st & 1) * 32 + (swz % 64) / 2; }
__host__ __device__ __forceinline__ int perm32(int rho) { const int n = rho >> 4, i = rho & 15; return 8 * (i >> 2) + 4 * n + (i & 3); }

struct Unit { int pm, pn; };
struct Gemm { const bf16_t* A; const bf16_t* Bt; int M, N, K; };

struct StaticOrder {
    int nM, nN, nwg, G, c;
    __host__ __device__ void init(int M, int N, int G_, int c_) { nM = M / BM; nN = N / BM; nwg = nM * nN; G = G_; c = c_; }
    __host__ __device__ bool next(int i, Unit& u) const {
        const long L = (long)i * G + c; if (L >= nwg) return false;
        int wgid = (int)L; { const int q = nwg / NXCD, r = nwg % NXCD, xcd = wgid % NXCD, off = wgid / NXCD; wgid = (xcd < r ? xcd * (q + 1) : r * (q + 1) + (xcd - r) * q) + off; }
        const int nig = WGM * nN, gid = wgid / nig, fm = gid * WGM, gsz = (nM - fm) < WGM ? (nM - fm) : WGM;
        u.pm = fm + ((wgid % nig) % gsz); u.pn = (wgid % nig) / gsz; return true;
    }
    __device__ __forceinline__ void a_ready(const Unit&) const {}
    __device__ __forceinline__ void done(const Unit&) const {}
};

template <class Epi, class Sched, bool ALIGN_EPI = false, bool SP2 = false>
__device__ __forceinline__ void gemm_phase(PG8_LAS unsigned char* lds, const Gemm g, const Sched& S, const Epi& E) {
    int tid_ = threadIdx.x; asm volatile("" : "+v"(tid_));
    const int tid = tid_, wid = __builtin_amdgcn_readfirstlane(tid >> 6), lane = tid & 63, wr = wid >> 2, wc = wid & 3, fr = lane & 15, fq = lane >> 4;
    const int K = g.K, nt = K / BK;
    unsigned voffA[2], voffB[2];
#pragma unroll
    for (int i = 0; i < 2; ++i) { int R, C; stage_rc(tid * 16 + i * 8192, R, C); const int Rb = Epi::PERM ? ((R & ~31) + perm32(R & 31)) : R;
        voffA[i] = (unsigned)(R * K + C) * 2u; voffB[i] = (unsigned)(Rb * K + C) * 2u; }
    const size_t kstep = (size_t)(BK * 2);
    const size_t hstep = (size_t)HALF * K * 2;
    const size_t tstep = 2 * hstep;
    const unsigned ldsw = (unsigned)wid * 1024u;
    const int aoff = lds_byte(wr * 64 + fr, fq * 8), boff = lds_byte(wc * 32 + fr, fq * 8);
#define PG8_SA(b, h) (((b) * 2 + (h)) * HTB)
#define PG8_SB(b, h) ((4 + (b) * 2 + (h)) * HTB)
#define PG8_STAGE(bufoff, gbase, voff) do { _Pragma("unroll") for (int _i = 0; _i < 2; ++_i) \
        __builtin_amdgcn_global_load_lds((const unsigned*)((const char*)(gbase) + (voff)[_i]), (PG8_LAS unsigned*)(lds + (bufoff) + ldsw + _i * 8192), 16, 0, 0); } while (0)
#define PG8_LDA(dst, b, h) do { _Pragma("unroll") for (int m = 0; m < 4; ++m) _Pragma("unroll") for (int k = 0; k < 2; ++k) dst[m][k] = *(const PG8_LAS bf16x8*)(lds + PG8_SA(b, h) + aoff + m * 2048 + k * 1024); } while (0)
#define PG8_LDB(dst, b, h) do { _Pragma("unroll") for (int n = 0; n < 2; ++n) _Pragma("unroll") for (int k = 0; k < 2; ++k) dst[n][k] = *(const PG8_LAS bf16x8*)(lds + PG8_SB(b, h) + boff + n * 2048 + k * 1024); } while (0)
#define PG8_MMA(ai, bj, At, Bt) do { __builtin_amdgcn_s_setprio(1); _Pragma("unroll") for (int m = 0; m < 4; ++m) _Pragma("unroll") for (int n = 0; n < 2; ++n) _Pragma("unroll") for (int k = 0; k < 2; ++k) \
        acc[ai][bj][m][n] = __builtin_amdgcn_mfma_f32_16x16x32_bf16(Bt[n][k], At[m][k], acc[ai][bj][m][n], 0, 0, 0); __builtin_amdgcn_s_setprio(0); } while (0)
#define PG8_WAIT_V(n) asm volatile("s_waitcnt vmcnt(" #n ")" ::: "memory")
#define PG8_WAIT_L(n) asm volatile("s_waitcnt lgkmcnt(" #n ")" ::: "memory")
#define PG8_BAR __builtin_amdgcn_s_barrier()
#define PG8_SCHED __builtin_amdgcn_sched_barrier(0)
    Unit cur, nxt; int ui = 0;
    if (!S.next(0, cur)) return;
    f32x4 acc[2][2][4][2];
#pragma unroll
    for (int a = 0; a < 2; ++a)
#pragma unroll
        for (int b = 0; b < 2; ++b)
#pragma unroll
            for (int m = 0; m < 4; ++m)
#pragma unroll
                for (int n = 0; n < 2; ++n) acc[a][b][m][n] = (f32x4){0.f, 0.f, 0.f, 0.f};
    bf16x8 At[4][2], B0[2][2], B1[2][2];
    const char* cA = (const char*)g.A + (size_t)cur.pm * tstep; const char* cB = (const char*)g.Bt + (size_t)cur.pn * tstep;
    S.a_ready(cur);
    if constexpr (SP2) {
        PG8_STAGE(PG8_SB(0, 0), cB, voffB); PG8_STAGE(PG8_SB(0, 1), cB + hstep, voffB); PG8_STAGE(PG8_SA(0, 0), cA, voffA); PG8_STAGE(PG8_SA(0, 1), cA + hstep, voffA);
        if (wr == 1) PG8_BAR;
        PG8_WAIT_V(2); PG8_BAR;
        PG8_STAGE(PG8_SB(1, 0), cB + kstep, voffB); PG8_STAGE(PG8_SA(1, 0), cA + kstep, voffA); PG8_STAGE(PG8_SB(1, 1), cB + hstep + kstep, voffB);
        PG8_WAIT_V(6); PG8_BAR;
    } else {
        PG8_STAGE(PG8_SB(0, 0), cB, voffB); PG8_STAGE(PG8_SA(0, 0), cA, voffA); PG8_STAGE(PG8_SB(0, 1), cB + hstep, voffB); PG8_STAGE(PG8_SA(0, 1), cA + hstep, voffA);
        if (wr == 1) PG8_BAR;
        PG8_WAIT_V(4); PG8_BAR;
        PG8_STAGE(PG8_SB(1, 0), cB + kstep, voffB); PG8_STAGE(PG8_SA(1, 0), cA + kstep, voffA); PG8_STAGE(PG8_SB(1, 1), cB + hstep + kstep, voffB);
        PG8_WAIT_V(6); PG8_BAR;
    }
    for (;;) {
        const bool has_next = S.next(ui + 1, nxt);
        const char* nA = has_next ? (const char*)g.A + (size_t)nxt.pm * tstep : cA; const char* nB = has_next ? (const char*)g.Bt + (size_t)nxt.pn * tstep : cB;
        for (int t = 0; t < nt; t += 2) {
            const bool last = (t == nt - 2);
            const char* a1 = cA + (size_t)(t + 1) * kstep;
            const char* a2 = last ? nA : cA + (size_t)(t + 2) * kstep; const char* b2 = last ? nB : cB + (size_t)(t + 2) * kstep;
            const char* a3 = a2 + kstep; const char* b3 = b2 + kstep;
            if (last && has_next) S.a_ready(nxt);
            if constexpr (SP2) {
            PG8_LDB(B0, 0, 0); PG8_LDB(B1, 0, 1); PG8_SCHED; PG8_LDA(At, 0, 0); PG8_STAGE(PG8_SA(1, 1), a1 + hstep, voffA);
            PG8_WAIT_V(8); PG8_WAIT_L(0); PG8_BAR; PG8_MMA(0, 0, At, B0); PG8_MMA(0, 1, At, B1); PG8_BAR; PG8_SCHED;
            PG8_LDA(At, 0, 1); PG8_STAGE(PG8_SB(0, 0), b2, voffB); PG8_STAGE(PG8_SB(0, 1), b2 + hstep, voffB); PG8_STAGE(PG8_SA(0, 0), a2, voffA);
            PG8_WAIT_V(8); PG8_WAIT_L(0); PG8_BAR; PG8_MMA(1, 0, At, B0); PG8_MMA(1, 1, At, B1); PG8_BAR; PG8_SCHED;
            PG8_LDB(B0, 1, 0); PG8_LDB(B1, 1, 1); PG8_SCHED; PG8_LDA(At, 1, 0); PG8_STAGE(PG8_SA(0, 1), a2 + hstep, voffA);
            PG8_WAIT_V(8); PG8_WAIT_L(0); PG8_BAR; PG8_MMA(0, 0, At, B0); PG8_MMA(0, 1, At, B1); PG8_BAR; PG8_SCHED;
            PG8_LDA(At, 1, 1); PG8_STAGE(PG8_SB(1, 0), b3, voffB); PG8_STAGE(PG8_SB(1, 1), b3 + hstep, voffB); PG8_STAGE(PG8_SA(1, 0), a3, voffA);
            PG8_WAIT_V(8); PG8_WAIT_L(0); PG8_BAR; PG8_MMA(1, 0, At, B0); PG8_MMA(1, 1, At, B1); PG8_BAR; PG8_SCHED;
            } else {
            PG8_LDB(B0, 0, 0); PG8_SCHED; PG8_LDA(At, 0, 0); PG8_STAGE(PG8_SA(1, 1), a1 + hstep, voffA);
            PG8_WAIT_L(8); PG8_BAR; PG8_WAIT_L(0); PG8_MMA(0, 0, At, B0); PG8_BAR; PG8_SCHED;
            PG8_LDB(B1, 0, 1); PG8_STAGE(PG8_SB(0, 0), b2, voffB);
            PG8_BAR; PG8_WAIT_L(0); PG8_MMA(0, 1, At, B1); PG8_BAR;
            PG8_LDA(At, 0, 1); PG8_STAGE(PG8_SA(0, 0), a2, voffA);
            PG8_BAR; PG8_WAIT_L(0); PG8_MMA(1, 0, At, B0); PG8_BAR; PG8_SCHED;
            PG8_STAGE(PG8_SB(0, 1), b2 + hstep, voffB);
            PG8_WAIT_V(6); PG8_BAR; PG8_MMA(1, 1, At, B1); PG8_BAR;
            PG8_LDB(B0, 1, 0); PG8_SCHED; PG8_LDA(At, 1, 0); PG8_STAGE(PG8_SA(0, 1), a2 + hstep, voffA);
            PG8_WAIT_L(8); PG8_BAR; PG8_WAIT_L(0); PG8_MMA(0, 0, At, B0); PG8_BAR; PG8_SCHED;
            PG8_LDB(B1, 1, 1); PG8_STAGE(PG8_SB(1, 0), b3, voffB);
            PG8_BAR; PG8_WAIT_L(0); PG8_MMA(0, 1, At, B1); PG8_BAR;
            PG8_LDA(At, 1, 1); PG8_STAGE(PG8_SA(1, 0), a3, voffA);
            PG8_BAR; PG8_WAIT_L(0); PG8_MMA(1, 0, At, B0); PG8_BAR; PG8_SCHED;
            PG8_STAGE(PG8_SB(1, 1), b3 + hstep, voffB);
            PG8_WAIT_V(6); PG8_BAR; PG8_MMA(1, 1, At, B1); PG8_BAR;
            }
            if constexpr (Epi::MID_HOOK) { if (t == Epi::MID_T) E.mid(acc, cur, wr, wc, fr, fq); }
        }
        if constexpr (ALIGN_EPI) { if (wr == 0) PG8_BAR; }
        if constexpr (!Epi::AFTER_DRAIN) { E(acc, cur, wr, wc, fr, fq); S.done(cur); }
        if (!has_next) break;
#pragma unroll
        for (int a = 0; a < 2; ++a)
#pragma unroll
            for (int b = 0; b < 2; ++b)
#pragma unroll
                for (int m = 0; m < 4; ++m)
#pragma unroll
                    for (int n = 0; n < 2; ++n) acc[a][b][m][n] = (f32x4){0.f, 0.f, 0.f, 0.f};
        cur = nxt; cA = nA; cB = nB; ++ui;
        if constexpr (ALIGN_EPI) { if (wr == 1) PG8_BAR; }
    }
    PG8_WAIT_V(0);
    if constexpr (!ALIGN_EPI) { if (wr == 0) PG8_BAR; }
    PG8_BAR;
    if constexpr (Epi::AFTER_DRAIN) { E.fused(acc, cur, wr, wc, fr, fq, lds, wid, lane); S.done(cur); }
#undef PG8_SA
#undef PG8_SB
#undef PG8_STAGE
#undef PG8_LDA
#undef PG8_LDB
#undef PG8_MMA
#undef PG8_WAIT_V
#undef PG8_WAIT_L
#undef PG8_BAR
#undef PG8_SCHED
}
}
#define LAS __attribute__((address_space(3)))
typedef unsigned short bf16_t;
typedef short bf16x8 __attribute__((ext_vector_type(8)));
typedef float f32x4 __attribute__((ext_vector_type(4)));
typedef float f32x2 __attribute__((ext_vector_type(2)));
typedef float f32x16 __attribute__((ext_vector_type(16)));
typedef unsigned u32x4 __attribute__((ext_vector_type(4)));
typedef unsigned u32x2 __attribute__((ext_vector_type(2)));
typedef __bf16 bf16x2_t __attribute__((ext_vector_type(2)));

constexpr int S = 16384, D = 1024, DEPTH = 4, NIN = 3584  , FF = 4096;
constexpr float EPS = 1e-6f;
constexpr float QSCALE = 0.125f * 1.4426950408889634f;
constexpr float LOG2E = 1.4426950408889634f;

__device__ __forceinline__ unsigned pk2(float lo, float hi) { f32x2 v = {lo, hi}; bf16x2_t b = __builtin_convertvector(v, bf16x2_t); return __builtin_bit_cast(unsigned, b); }
__device__ __forceinline__ float bf2f(bf16_t v) { return __uint_as_float(((unsigned)v) << 16); }
__device__ __forceinline__ bf16_t f2bf(float f) { return (bf16_t)(pk2(f, 0.f) & 0xffffu); }
__device__ __forceinline__ float wave_sum(float v) {
#pragma unroll
    for (int o = 1; o < 64; o <<= 1) v += __shfl_xor(v, o);
    return v;
}
__device__ __forceinline__ float half_swap_sum(float v) { auto rr = __builtin_amdgcn_permlane32_swap(__float_as_uint(v), __float_as_uint(v), false, false); return __uint_as_float(rr[0]) + __uint_as_float(rr[1]); }
__device__ __forceinline__ float half_swap_max(float v) { auto rr = __builtin_amdgcn_permlane32_swap(__float_as_uint(v), __float_as_uint(v), false, false); return fmaxf(__uint_as_float(rr[0]), __uint_as_float(rr[1])); }

__device__ __forceinline__ float row_rstd(const float* ssq, int row) {
    const f32x4* p = (const f32x4*)(ssq + (size_t)row * 16);
    const f32x4 a = p[0], b = p[1], c = p[2], d = p[3];
    const f32x4 s = (a + b) + (c + d);
    const float t = (s[0] + s[1]) + (s[2] + s[3]);
    return __builtin_amdgcn_rsqf(t * (1.f / 1024.f) + EPS);
}

using pg8::Unit;
typedef f32x4 acc_t[2][2][4][2];

struct EpiInProj {
    static constexpr bool PERM = true, AFTER_DRAIN = false, MID_HOOK = false; static constexpr int MID_T = -1;
    const float* ssq; bf16_t* Q; bf16_t* Kb; bf16_t* xp; bf16_t* gates; const float* qg; const float* kg; const float* bg;
    __device__ __forceinline__ void operator()(const acc_t& acc, const Unit& u, int wr, int wc, int fr, int fq) const {
        const int row0 = u.pm * 256 + wr * 64 + fr, pn = u.pn;
        if (pn < 4) {
            const bool isq = pn < 2; const float* g = isq ? qg : kg; const float sc = isq ? QSCALE : 1.f;
            bf16_t* base = (isq ? Q : Kb) + (size_t)((pn & 1) * 4 + wc) * S * 64;
            f32x4 gv[2][2];
#pragma unroll
            for (int bj = 0; bj < 2; ++bj)
#pragma unroll
                for (int n = 0; n < 2; ++n) gv[bj][n] = *(const f32x4*)(g + 32 * bj + 8 * fq + 4 * n) * sc;
#pragma unroll
            for (int ai = 0; ai < 2; ++ai)
#pragma unroll
                for (int m = 0; m < 4; ++m) {
                    const int row = row0 + ai * 128 + m * 16; const float rs = row_rstd(ssq, row);
                    f32x4 v[2][2]; float ss = 0.f;
#pragma unroll
                    for (int bj = 0; bj < 2; ++bj)
#pragma unroll
                        for (int n = 0; n < 2; ++n) { v[bj][n] = acc[ai][bj][m][n] * rs; const f32x4 q2 = v[bj][n] * v[bj][n]; ss += (q2[0] + q2[1]) + (q2[2] + q2[3]); }
                    ss += __shfl_xor(ss, 16); ss += __shfl_xor(ss, 32);
                    const float r2 = __builtin_amdgcn_rsqf(ss * (1.f / 64.f) + EPS);
#pragma unroll
                    for (int bj = 0; bj < 2; ++bj) { const f32x4 a = v[bj][0] * r2 * gv[bj][0], b = v[bj][1] * r2 * gv[bj][1];
                        u32x4 w; w.x = pk2(a[0], a[1]); w.y = pk2(a[2], a[3]); w.z = pk2(b[0], b[1]); w.w = pk2(b[2], b[3]);
                        *(u32x4*)(base + (size_t)row * 64 + 32 * bj + 8 * fq) = w; }
                }
        } else if (pn < 6) {
            const int col0 = (pn - 4) * 256 + wc * 32 + 8 * fq;
#pragma unroll
            for (int ai = 0; ai < 2; ++ai)
#pragma unroll
                for (int m = 0; m < 4; ++m) {
                    const int row = row0 + ai * 128 + m * 16; const float rs = row_rstd(ssq, row);
#pragma unroll
                    for (int bj = 0; bj < 2; ++bj) { const f32x4 a = acc[ai][bj][m][0] * rs, b = acc[ai][bj][m][1] * rs;
                        u32x4 w; w.x = pk2(a[0], a[1]); w.y = pk2(a[2], a[3]); w.z = pk2(b[0], b[1]); w.w = pk2(b[2], b[3]);
                        *(u32x4*)(xp + (size_t)row * 512 + col0 + bj * 128) = w; }
                }
        } else {
            const int col0 = (pn - 6) * 256 + wc * 32 + 8 * fq;
            f32x4 bv[2][2];
#pragma unroll
            for (int bj = 0; bj < 2; ++bj)
#pragma unroll
                for (int n = 0; n < 2; ++n) bv[bj][n] = *(const f32x4*)(bg + col0 + bj * 128 + 4 * n) * (-LOG2E);
#pragma unroll
            for (int ai = 0; ai < 2; ++ai)
#pragma unroll
                for (int m = 0; m < 4; ++m) {
                    const int row = row0 + ai * 128 + m * 16; const float rs = row_rstd(ssq, row) * (-LOG2E);
#pragma unroll
                    for (int bj = 0; bj < 2; ++bj) { f32x4 a = acc[ai][bj][m][0] * rs + bv[bj][0], b = acc[ai][bj][m][1] * rs + bv[bj][1];
#pragma unroll
                        for (int j = 0; j < 4; ++j) { a[j] = __builtin_amdgcn_rcpf(1.f + __builtin_amdgcn_exp2f(a[j])); b[j] = __builtin_amdgcn_rcpf(1.f + __builtin_amdgcn_exp2f(b[j])); }
                        u32x4 w; w.x = pk2(a[0], a[1]); w.y = pk2(a[2], a[3]); w.z = pk2(b[0], b[1]); w.w = pk2(b[2], b[3]);
                        *(u32x4*)(gates + (size_t)row * 2048 + col0 + bj * 128) = w; }
                }
        }
    }
};

struct EpiVT {
    static constexpr bool PERM = false, AFTER_DRAIN = false, MID_HOOK = false; static constexpr int MID_T = -1;
    const float* ssq; bf16_t* VT;
    __device__ __forceinline__ void operator()(const acc_t& acc, const Unit& u, int wr, int wc, int fr, int fq) const {
        const int f0 = u.pm * 256 + wr * 64 + fr; const int sfq = ((fq & 1) << 1) | (fq >> 1);
#pragma unroll
        for (int bj = 0; bj < 2; ++bj)
#pragma unroll
            for (int n = 0; n < 2; ++n) {
                const int tg = u.pn * 256 + bj * 128 + wc * 32 + n * 16; const int tok = tg + 4 * fq;
                f32x4 rs; rs[0] = row_rstd(ssq, tok); rs[1] = row_rstd(ssq, tok + 1); rs[2] = row_rstd(ssq, tok + 2); rs[3] = row_rstd(ssq, tok + 3);
#pragma unroll
                for (int ai = 0; ai < 2; ++ai)
#pragma unroll
                    for (int m = 0; m < 4; ++m) { const f32x4 v = acc[ai][bj][m][n] * rs; u32x2 w; w.x = pk2(v[0], v[1]); w.y = pk2(v[2], v[3]);
                        const int f = f0 + ai * 128 + m * 16;
                        *(u32x2*)(VT + ((size_t)((f >> 7) * 256 + (tg >> 6)) * 128 + (f & 127)) * 64 + (tg & 63) + 4 * sfq) = w; }
            }
    }
};

struct EpiUp {
    static constexpr bool PERM = true, AFTER_DRAIN = false, MID_HOOK = true; static constexpr int MID_T = 6;
    const bf16_t* gates; bf16_t* merged;
    static __device__ __forceinline__ void unpack8(const u32x4 w, f32x4& a, f32x4& b) {
        a[0] = __uint_as_float(w.x << 16); a[1] = __uint_as_float(w.x & 0xffff0000u); a[2] = __uint_as_float(w.y << 16); a[3] = __uint_as_float(w.y & 0xffff0000u);
        b[0] = __uint_as_float(w.z << 16); b[1] = __uint_as_float(w.z & 0xffff0000u); b[2] = __uint_as_float(w.w << 16); b[3] = __uint_as_float(w.w & 0xffff0000u);
    }
    __device__ __forceinline__ void mid(acc_t& acc, const Unit& u, int, int, int, int) const {
        int tid = threadIdx.x; asm volatile("" : "+v"(tid));
        const int wid = tid >> 6, lane = tid & 63, wr = wid >> 2, wc = wid & 3, fr = lane & 15, fq = lane >> 4;
        const int row0 = u.pm * 256 + wr * 64 + fr, col0 = u.pn * 256 + wc * 32 + 8 * fq;
#pragma unroll
        for (int ai = 0; ai < 2; ++ai)
#pragma unroll
            for (int m = 0; m < 4; ++m) { const bf16_t* gr = gates + (size_t)(row0 + ai * 128 + m * 16) * 2048 + col0;
#pragma unroll
                for (int bj = 0; bj < 2; ++bj) { f32x4 a0, a1, b0, b1; unpack8(*(const u32x4*)(gr + bj * 128), a0, a1); unpack8(*(const u32x4*)(gr + 1024 + bj * 128), b0, b1);
#pragma unroll
                    for (int j = 0; j < 4; ++j) { a0[j] *= __builtin_amdgcn_rcpf(fmaxf(b0[j], 1e-20f)); a1[j] *= __builtin_amdgcn_rcpf(fmaxf(b1[j], 1e-20f)); }
                    acc[ai][bj][m][0] *= a0; acc[ai][bj][m][1] *= a1; }
                asm volatile("" ::: "memory"); }
    }
    __device__ __forceinline__ void operator()(const acc_t& acc, const Unit& u, int wr, int wc, int fr, int fq) const {
        const int row0 = u.pm * 256 + wr * 64 + fr, col0 = u.pn * 256 + wc * 32 + 8 * fq;
#pragma unroll
        for (int ai = 0; ai < 2; ++ai)
#pragma unroll
            for (int m = 0; m < 4; ++m) { const int row = row0 + ai * 128 + m * 16; const bf16_t* gr = gates + (size_t)row * 2048 + 1024 + col0;
#pragma unroll
                for (int bj = 0; bj < 2; ++bj) { f32x4 b0, b1; unpack8(*(const u32x4*)(gr + bj * 128), b0, b1);
#pragma unroll
                    for (int j = 0; j < 4; ++j) { b0[j] = fmaxf(b0[j], 1e-20f); b1[j] = fmaxf(b1[j], 1e-20f); }
                    const f32x4 a = acc[ai][bj][m][0] * b0, b = acc[ai][bj][m][1] * b1;
                    u32x4 w; w.x = pk2(a[0], a[1]); w.y = pk2(a[2], a[3]); w.z = pk2(b[0], b[1]); w.w = pk2(b[2], b[3]);
                    *(u32x4*)(merged + (size_t)row * 1024 + col0 + bj * 128) = w; } }
    }
};
struct EpiResid {
    static constexpr bool PERM = false, AFTER_DRAIN = false, MID_HOOK = false; static constexpr int MID_T = -1;
    const float* xin; float* xout; bf16_t* xb; float* ssq;
    __device__ __forceinline__ void operator()(const acc_t& acc, const Unit& u, int wr, int wc, int fr, int fq) const {
        const int row0 = u.pm * 256 + wr * 64 + fr, col0 = u.pn * 256 + wc * 32 + 4 * fq;
#pragma unroll
        for (int ai = 0; ai < 2; ++ai)
#pragma unroll
            for (int m = 0; m < 4; ++m) { const int row = row0 + ai * 128 + m * 16; float ss = 0.f;
#pragma unroll
                for (int bj = 0; bj < 2; ++bj)
#pragma unroll
                    for (int n = 0; n < 2; ++n) { const size_t off = (size_t)row * 1024 + col0 + bj * 128 + n * 16;
                        const f32x4 v = *(const f32x4*)(xin + off) + acc[ai][bj][m][n];
                        *(f32x4*)(xout + off) = v; u32x2 w; w.x = pk2(v[0], v[1]); w.y = pk2(v[2], v[3]); *(u32x2*)(xb + off) = w;
                        const f32x4 q2 = v * v; ss += (q2[0] + q2[1]) + (q2[2] + q2[3]); }
                ss += __shfl_xor(ss, 16); ss += __shfl_xor(ss, 32);
                if (fq == 0) ssq[(size_t)row * 16 + u.pn * 4 + wc] = ss; }
    }
};
struct EpiMlpIn {
    static constexpr bool PERM = true, AFTER_DRAIN = false, MID_HOOK = false; static constexpr int MID_T = -1;
    const float* ssq; bf16_t* U;
    __device__ __forceinline__ void operator()(const acc_t& acc, const Unit& u, int wr, int wc, int fr, int fq) const {
        const int row0 = u.pm * 256 + wr * 64 + fr, col0 = u.pn * 256 + wc * 32 + 8 * fq;
#pragma unroll
        for (int ai = 0; ai < 2; ++ai)
#pragma unroll
            for (int m = 0; m < 4; ++m) { const int row = row0 + ai * 128 + m * 16; const float rs = row_rstd(ssq, row);
#pragma unroll
                for (int bj = 0; bj < 2; ++bj) { f32x4 a = acc[ai][bj][m][0] * rs, b = acc[ai][bj][m][1] * rs;
#pragma unroll
                    for (int j = 0; j < 4; ++j) { a[j] = fmaxf(a[j], 0.f); a[j] *= a[j]; b[j] = fmaxf(b[j], 0.f); b[j] *= b[j]; }
                    u32x4 w; w.x = pk2(a[0], a[1]); w.y = pk2(a[2], a[3]); w.z = pk2(b[0], b[1]); w.w = pk2(b[2], b[3]);
                    *(u32x4*)(U + (size_t)row * FF + col0 + bj * 128) = w; } }
    }
};
constexpr size_t MiB = 1u << 20;
constexpr size_t WS_SSQ = 0;
constexpr size_t WS_WIN = 1 * MiB, WS_WV = 8 * MiB, WS_WUA = 9 * MiB, WS_WPP = 10 * MiB, WS_WO = 11 * MiB, WS_W1 = 13 * MiB, WS_W2 = 21 * MiB;
constexpr size_t WS_BAR = 29 * MiB;
constexpr size_t WS_XB = 32 * MiB;
constexpr size_t WS_Q = 64 * MiB, WS_K = 80 * MiB, WS_VT = 96 * MiB, WS_XP = 112 * MiB, WS_GATES = 128 * MiB;
constexpr size_t WS_U = 64 * MiB;
constexpr size_t WS_A = 192 * MiB  , WS_MERGED = 224 * MiB, WS_END = 256 * MiB;
constexpr int LDS_BYTES = 131072 + 1024;

__device__ __forceinline__ void transpose_item(const float* W, int ldw, int Kd, const float* gk, bf16_t* WTrow0, int k0, int n0, LAS float* scr, int lane) {
    float tv[32];
#pragma unroll
    for (int i = 0; i < 32; ++i) tv[i] = W[(size_t)(k0 + 2 * i + (lane >> 5)) * ldw + n0 + (lane & 31)];
    if (gk) {
        float gvv[32];
#pragma unroll
        for (int i = 0; i < 32; ++i) gvv[i] = gk[k0 + 2 * i + (lane >> 5)];
#pragma unroll
        for (int i = 0; i < 32; ++i) tv[i] *= gvv[i];
    }
#pragma unroll
    for (int i = 0; i < 32; ++i) scr[(2 * i + (lane >> 5)) * 33 + (lane & 31)] = tv[i];
    asm volatile("s_waitcnt lgkmcnt(0)" ::: "memory");
    const int c = lane & 7;
#pragma unroll
    for (int j = 0; j < 4; ++j) { const int n = (lane >> 3) + 8 * j; const LAS float* s = scr + (8 * c) * 33 + n;
        u32x4 o; o.x = pk2(s[0 * 33], s[1 * 33]); o.y = pk2(s[2 * 33], s[3 * 33]); o.z = pk2(s[4 * 33], s[5 * 33]); o.w = pk2(s[6 * 33], s[7 * 33]);
        *(u32x4*)(WTrow0 + (size_t)n * Kd + k0 + 8 * c) = o; }
    asm volatile("s_waitcnt lgkmcnt(0)" ::: "memory");
}

struct Params {
    const float *x, *norm1_g, *w_in, *b_gate, *q_norm_g, *k_norm_g, *lam_params, *subln_g, *pool_w, *pool_scale, *w_up_attn, *w_up_pool, *w_o, *norm2_g, *w_mlp_in, *w_mlp_out;
    float* out; unsigned char* ws;
};

__device__ __forceinline__ void prep_phase(const Params& p, int l, LAS unsigned char* lds) {
    int tid_ = threadIdx.x; asm volatile("" : "+v"(tid_));
    const int lane = tid_ & 63, wave = __builtin_amdgcn_readfirstlane(tid_ >> 6);
    LAS float* scr = (LAS float*)(lds + wave * 16384);
    const int gw = blockIdx.x * 8 + wave, NGW = gridDim.x * 8;
    unsigned char* ws = p.ws;
    bf16_t* WinT = (bf16_t*)(ws + WS_WIN); bf16_t* WvT = (bf16_t*)(ws + WS_WV); bf16_t* WuaT = (bf16_t*)(ws + WS_WUA);
    bf16_t* WoT = (bf16_t*)(ws + WS_WO); bf16_t* W1T = (bf16_t*)(ws + WS_W1); bf16_t* W2T = (bf16_t*)(ws + WS_W2);
    const float* w_in = p.w_in + (size_t)l * D * 4096; const float* g1 = p.norm1_g + l * D; const float* g2 = p.norm2_g + l * D;
    const float* wua = p.w_up_attn + (size_t)l * 512 * D; const float* wup = p.w_up_pool + (size_t)l * 512 * D; const float* wo = p.w_o + (size_t)l * D * D;
    const float* w1 = p.w_mlp_in + (size_t)l * D * FF; const float* w2 = p.w_mlp_out + (size_t)l * FF * D;
    const float* pw = p.pool_w + (size_t)l * 4 * 128 * 128; const float* ps = p.pool_scale + l * 512;
    constexpr int I_PP = 2048, I_IN = 16 * 128, I_UA = 8 * 32, I_O = 16 * 32, I_1 = 16 * 128, I_2 = 64 * 32;
    constexpr int NITEMS = I_PP + I_IN + I_UA + I_O + I_1 + I_2;
    for (int it = gw; it < NITEMS; it += NGW) {
        int r = it;
        if (r < I_PP) {
            const int g = r >> 9, d0 = ((r >> 1) & 255) * 4, cblk = r & 1; const int c = cblk * 64 + lane;
            const float* pwr = pw + (size_t)(g * 128 + c) * 128; const float* psg = ps + g * 128; const float* wu = wup + (size_t)(g * 128) * D + d0;
            f32x4 pwv[32];
#pragma unroll
            for (int jj = 0; jj < 32; ++jj) pwv[jj] = *(const f32x4*)(pwr + 4 * jj);
#pragma unroll
            for (int i = 0; i < 8; ++i) { const int idx = i * 64 + lane; scr[idx] = wu[(size_t)(idx >> 2) * D + (idx & 3)]; }
            asm volatile("s_waitcnt lgkmcnt(0)" ::: "memory");
            f32x4 acc = {0.f, 0.f, 0.f, 0.f};
#pragma unroll
            for (int jj = 0; jj < 32; ++jj) { const f32x4 a4 = pwv[jj] * *(const f32x4*)(psg + 4 * jj);
#pragma unroll
                for (int t = 0; t < 4; ++t) acc += *(const LAS f32x4*)(scr + (4 * jj + t) * 4) * a4[t]; }
#pragma unroll
            for (int dd = 0; dd < 4; ++dd) WuaT[(size_t)(d0 + dd) * 1024 + 512 + g * 128 + c] = f2bf(acc[dd]);
            asm volatile("s_waitcnt lgkmcnt(0)" ::: "memory");
            continue;
        }
        r -= I_PP;
        if (r < I_IN) { const int kb = r >> 7, nb = r & 127, n0 = nb * 32; bf16_t* dst;
            if (n0 < 1024) dst = WinT + (size_t)((n0 & ~255) + 128 * ((n0 >> 5) & 1) + 32 * ((n0 >> 6) & 3)) * D;
            else if (n0 < 1536) dst = WvT + (size_t)(n0 - 1024) * D;
            else dst = WinT + (size_t)(n0 - 512) * D;
            transpose_item(w_in, 4096, D, g1, dst, kb * 64, n0, scr, lane); continue; }
        r -= I_IN;
        if (r < I_UA) { const int kb = r >> 5, nb = r & 31; transpose_item(wua, D, 1024, nullptr, WuaT + (size_t)(nb * 32) * 1024, kb * 64, nb * 32, scr, lane); continue; }
        r -= I_UA;
        if (r < I_O) { const int kb = r >> 5, nb = r & 31; transpose_item(wo, D, D, nullptr, WoT + (size_t)(nb * 32) * D, kb * 64, nb * 32, scr, lane); continue; }
        r -= I_O;
        if (r < I_1) { const int kb = r >> 7, nb = r & 127; transpose_item(w1, FF, D, g2, W1T + (size_t)(nb * 32) * D, kb * 64, nb * 32, scr, lane); continue; }
        r -= I_1;
        { const int kb = r >> 5, nb = r & 31; transpose_item(w2, D, FF, nullptr, W2T + (size_t)(nb * 32) * FF, kb * 64, nb * 32, scr, lane); }
    }
    if (l == 0) {
        bf16_t* xb = (bf16_t*)(ws + WS_XB); float* ssq = (float*)(ws + WS_SSQ);
        for (int m = gw; m < S; m += NGW) {
            const f32x4* xr = (const f32x4*)(p.x + (size_t)m * D) + lane; u32x2* o8 = (u32x2*)(xb + (size_t)m * D) + lane; float s = 0.f;
#pragma unroll
            for (int j = 0; j < 4; ++j) { const f32x4 v = xr[64 * j]; s += (v[0] * v[0] + v[1] * v[1]) + (v[2] * v[2] + v[3] * v[3]); u32x2 w; w.x = pk2(v[0], v[1]); w.y = pk2(v[2], v[3]); o8[64 * j] = w; }
            s = wave_sum(s);
            if (lane < 16) ssq[(size_t)m * 16 + lane] = lane == 0 ? s : 0.f;
        }
    }
}

template <int W> __device__ __forceinline__ void pool_tile(const bf16_t* xp, bf16_t* pooled, int t0, int ch0) {
    u32x4 prev[W], cur[8];
#pragma unroll
    for (int k = 0; k < W; ++k) { const int t = t0 - W + k; prev[k] = t >= 0 ? *(const u32x4*)(xp + (size_t)t * 512 + ch0) : (u32x4){0u, 0u, 0u, 0u}; }
#pragma unroll
    for (int i = 0; i < 8; ++i) cur[i] = *(const u32x4*)(xp + (size_t)(t0 + i) * 512 + ch0);
    float s[8];
#pragma unroll
    for (int c = 0; c < 8; ++c) s[c] = 0.f;
#pragma unroll
    for (int k = 0; k < W; ++k)
#pragma unroll
        for (int c = 0; c < 4; ++c) { s[2 * c] += __uint_as_float(prev[k][c] << 16); s[2 * c + 1] += __uint_as_float(prev[k][c] & 0xffff0000u); }
#pragma unroll
    for (int i = 0; i < 8; ++i) {
        const u32x4 old = i < W ? prev[i < W ? i : 0] : cur[i >= W ? i - W : 0];
        const int t = t0 + i; const float cnt = (float)(t + 1 < W ? t + 1 : W);
        u32x4 o;
#pragma unroll
        for (int c = 0; c < 4; ++c) {
            const float c0 = __uint_as_float(cur[i][c] << 16), c1 = __uint_as_float(cur[i][c] & 0xffff0000u);
            s[2 * c] += c0 - __uint_as_float(old[c] << 16); s[2 * c + 1] += c1 - __uint_as_float(old[c] & 0xffff0000u);
            o[c] = pk2(s[2 * c] / cnt - c0, s[2 * c + 1] / cnt - c1);
        }
        *(u32x4*)(pooled + (size_t)t * 1024 + 512 + ch0) = o;
    }
}
__device__ __forceinline__ void pool_phase(const bf16_t* xp, bf16_t* pooled) {
    int tid_ = threadIdx.x; asm volatile("" : "+v"(tid_));
    const int lane = tid_ & 63, wave = __builtin_amdgcn_readfirstlane(tid_ >> 6);
    const int g = wave & 3, ch0 = g * 128 + (lane & 15) * 8, tsub = (wave >> 2) * 32 + (lane >> 4) * 8;
    for (int chunk = blockIdx.x; chunk < S / 64; chunk += gridDim.x) {
        const int t0 = chunk * 64 + tsub;
        if (g == 0) pool_tile<2>(xp, pooled, t0, ch0); else if (g == 1) pool_tile<4>(xp, pooled, t0, ch0); else if (g == 2) pool_tile<8>(xp, pooled, t0, ch0); else pool_tile<16>(xp, pooled, t0, ch0);
    }
}

constexpr int AT_ROWB = 144, AT_K2 = 64 * AT_ROWB, AT_KST = 2 * AT_K2  , AT_VST = 128 * AT_ROWB  , AT_VOFF = 2 * AT_KST;
#define MFMA32(a, b, c) __builtin_amdgcn_mfma_f32_32x32x16_bf16((a), (b), (c), 0, 0, 0)

__device__ __forceinline__ float at_max3(float a, float b, float c) { float r; asm("v_max3_f32 %0, %1, %2, %3" : "=v"(r) : "v"(a), "v"(b), "v"(c)); return r; }
__device__ __forceinline__ void at_qk_half(const bool ONLINE, const LAS unsigned char* kp, const bf16x8 (&qf)[4], int q, int q0, int kbase, int hh, float& mrun, f32x16 (&O)[4], f32x16& L, bf16x8 (&pf)[4]) {
    __builtin_amdgcn_s_setprio(3);
    bf16x8 kf[8];
#pragma unroll
    for (int s = 0; s < 4; ++s) { kf[2 * s] = *(const LAS bf16x8*)(kp + 32 * s); kf[2 * s + 1] = *(const LAS bf16x8*)(kp + 32 * AT_ROWB + 32 * s); }
    __builtin_amdgcn_sched_barrier(0);
    f32x16 s0, s1;
#pragma unroll
    for (int i = 0; i < 16; ++i) { s0[i] = 0.f; s1[i] = 0.f; }
#pragma unroll
    for (int s = 0; s < 4; ++s) { s0 = MFMA32(kf[2 * s], qf[s], s0); s1 = MFMA32(kf[2 * s + 1], qf[s], s1); }
    if (kbase + 63 > q0) {
        const int kb = kbase + 4 * hh;
#pragma unroll
        for (int i = 0; i < 16; ++i) { const int kv = kb + (i & 3) + 8 * (i >> 2); if (kv > q) s0[i] = -INFINITY; if (kv + 32 > q) s1[i] = -INFINITY; }
    }
    if (ONLINE) {
#pragma unroll
        for (int i = 0; i < 16; ++i) { s0[i] -= mrun; s1[i] -= mrun; }
        float mx = fmaxf(s0[0], s1[0]);
#pragma unroll
        for (int i = 1; i < 16; ++i) mx = at_max3(mx, s0[i], s1[i]);
        mx = half_swap_max(mx);
        if (__builtin_amdgcn_ballot_w64(mx > 8.f) != 0ull) {
            const float d = fmaxf(mx, 0.f); const float alpha = __builtin_amdgcn_exp2f(-d); mrun += d;
#pragma unroll
            for (int e = 0; e < 4; ++e)
#pragma unroll
                for (int i = 0; i < 16; ++i) O[e][i] *= alpha;
#pragma unroll
            for (int i = 0; i < 16; ++i) { L[i] *= alpha; s0[i] -= d; s1[i] -= d; }
        }
    }
#pragma unroll
    for (int i = 0; i < 16; ++i) { s0[i] = __builtin_amdgcn_exp2f(s0[i]); s1[i] = __builtin_amdgcn_exp2f(s1[i]); }
#pragma unroll
    for (int s2 = 0; s2 < 2; ++s2) {
        u32x4 a, b;
        a.x = pk2(s0[8 * s2 + 0], s0[8 * s2 + 1]); a.y = pk2(s0[8 * s2 + 2], s0[8 * s2 + 3]); a.z = pk2(s0[8 * s2 + 4], s0[8 * s2 + 5]); a.w = pk2(s0[8 * s2 + 6], s0[8 * s2 + 7]);
        b.x = pk2(s1[8 * s2 + 0], s1[8 * s2 + 1]); b.y = pk2(s1[8 * s2 + 2], s1[8 * s2 + 3]); b.z = pk2(s1[8 * s2 + 4], s1[8 * s2 + 5]); b.w = pk2(s1[8 * s2 + 6], s1[8 * s2 + 7]);
        pf[s2] = __builtin_bit_cast(bf16x8, a); pf[2 + s2] = __builtin_bit_cast(bf16x8, b);
    }
    __builtin_amdgcn_s_setprio(0);
}
__device__ __forceinline__ void at_pv_half(const LAS unsigned char* vp, const bf16x8 (&pf)[4], f32x16 (&O)[4], f32x16& L) {
    bf16x8 va[8], vb[8];
#pragma unroll
    for (int e = 0; e < 2; ++e)
#pragma unroll
        for (int ks = 0; ks < 4; ++ks) va[e * 4 + ks] = *(const LAS bf16x8*)(vp + e * 32 * AT_ROWB + 32 * ks);
#pragma unroll
    for (int e = 0; e < 2; ++e)
#pragma unroll
        for (int ks = 0; ks < 4; ++ks) vb[e * 4 + ks] = *(const LAS bf16x8*)(vp + (2 + e) * 32 * AT_ROWB + 32 * ks);
    const short one = (short)0x3F80; const bf16x8 ones = {one, one, one, one, one, one, one, one};
    __builtin_amdgcn_sched_barrier(0);
#pragma unroll
    for (int ks = 0; ks < 4; ++ks) L = MFMA32(ones, pf[ks], L);
    __builtin_amdgcn_sched_barrier(0);
#pragma unroll
    for (int ks = 0; ks < 4; ++ks) { O[0] = MFMA32(va[ks], pf[ks], O[0]); O[1] = MFMA32(va[4 + ks], pf[ks], O[1]); }
#pragma unroll
    for (int ks = 0; ks < 4; ++ks) { O[2] = MFMA32(vb[ks], pf[ks], O[2]); O[3] = MFMA32(vb[4 + ks], pf[ks], O[3]); }
}

__device__ __forceinline__ void attn_item(LAS unsigned char* lds, const bf16_t* Q, const bf16_t* Kb, const bf16_t* VT, bf16_t* aout, const float* subg, float lam, float omli, float kbound, int head, int qb) {
    int tid_ = threadIdx.x; asm volatile("" : "+v"(tid_));
    const int tid = tid_, lane = tid & 63, r = lane & 31, hh = lane >> 5; const int wid = __builtin_amdgcn_readfirstlane(tid >> 6);
    const int comp = wid >> 2, qt = wid & 3; const int q0 = qb * 128 + qt * 32, q = q0 + r; const int nt = 2 * qb + 2;
    bf16x8 qf[4];
    { const bf16_t* Qp = Q + ((size_t)(head * 2 + comp) * S + q) * 64 + 8 * hh;
#pragma unroll
      for (int s = 0; s < 4; ++s) qf[s] = *(const bf16x8*)(Qp + 16 * s); }
    const int srow = tid >> 3, sch = tid & 7;
    const char* bK1 = (const char*)(Kb + (size_t)(head * 2 + 0) * S * 64); const char* bK2 = (const char*)(Kb + (size_t)(head * 2 + 1) * S * 64);
    const char* bV0 = (const char*)(VT + (size_t)head * 256 * 128 * 64); const char* bV1 = bV0 + 8192;
    const unsigned koff = srow * 128 + sch * 16, voff = koff;
    const unsigned dK1 = srow * AT_ROWB + sch * 16, dK2 = AT_K2 + dK1, dV0 = AT_VOFF + dK1, dV1 = AT_VOFF + 64 * AT_ROWB + dK1;
    u32x4 ks0 = *(const u32x4*)(bK1 + koff), ks1 = *(const u32x4*)(bK2 + koff), vs0 = *(const u32x4*)(bV0 + voff), vs1 = *(const u32x4*)(bV1 + voff);
    *(LAS u32x4*)(lds + dK1) = ks0; *(LAS u32x4*)(lds + dK2) = ks1; *(LAS u32x4*)(lds + dV0) = vs0; *(LAS u32x4*)(lds + dV1) = vs1;
    ks0 = *(const u32x4*)(bK1 + 8192 + koff); ks1 = *(const u32x4*)(bK2 + 8192 + koff);
    asm volatile("" : "+v"(qf[0]), "+v"(qf[1]), "+v"(qf[2]), "+v"(qf[3]));
    __syncthreads();
    f32x16 O[4];
#pragma unroll
    for (int e = 0; e < 4; ++e)
#pragma unroll
        for (int i = 0; i < 16; ++i) O[e][i] = 0.f;
    float qn2 = 0.f;
#pragma unroll
    for (int s = 0; s < 4; ++s)
#pragma unroll
        for (int e = 0; e < 8; ++e) { const float v = bf2f((bf16_t)qf[s][e]); qn2 += v * v; }
    const float sbound = __builtin_sqrtf(half_swap_sum(qn2)) * kbound;
    const bool online = __builtin_amdgcn_ballot_w64(!(sbound <= 100.f)) != 0ull;
    float mrun = 0.f;
    f32x16 L;
#pragma unroll
    for (int i = 0; i < 16; ++i) L[i] = 0.f;
    bf16x8 pf[4];
#pragma unroll
    for (int i = 0; i < 4; ++i) pf[i] = (bf16x8){0, 0, 0, 0, 0, 0, 0, 0};
    const unsigned kfo = comp * AT_K2 + r * AT_ROWB + 16 * hh, vfo = AT_VOFF + r * AT_ROWB + 16 * hh;
    const int qmax = q0 + 31, ntm1 = nt - 1;
#define AT_ISSUE_V(jn) do { const int jc_ = (jn) < ntm1 ? (jn) : ntm1; const size_t vo_ = (size_t)jc_ * 16384; vs0 = *(const u32x4*)(bV0 + vo_ + voff); vs1 = *(const u32x4*)(bV1 + vo_ + voff); } while (0)
#define AT_ISSUE_K(jn) do { const int jc_ = (jn) < ntm1 ? (jn) : ntm1; const size_t ko_ = (size_t)jc_ * 8192; ks0 = *(const u32x4*)(bK1 + ko_ + koff); ks1 = *(const u32x4*)(bK2 + ko_ + koff); } while (0)
#define AT_WRITE_K(jn) do { LAS unsigned char* n_ = lds + ((jn) & 1) * AT_KST; *(LAS u32x4*)(n_ + dK1) = ks0; *(LAS u32x4*)(n_ + dK2) = ks1; } while (0)
#define AT_WRITE_V(jn) do { LAS unsigned char* n_ = lds + ((jn) & 1) * AT_KST; *(LAS u32x4*)(n_ + dV0) = vs0; *(LAS u32x4*)(n_ + dV1) = vs1; } while (0)
    if (comp == 0) {
        for (int j = 0; j < nt; ++j) {
            const LAS unsigned char* stg = lds + (j & 1) * AT_KST; const int kbase = j * 64; const bool act = kbase <= qmax;
            __builtin_amdgcn_s_setprio(3);
            AT_ISSUE_V(j + 1);
            if (act) at_qk_half(online, stg + kfo, qf, q, q0, kbase, hh, mrun, O, L, pf);
            __builtin_amdgcn_s_setprio(3);
            AT_WRITE_K(j + 1);
            __syncthreads();
            __builtin_amdgcn_s_setprio(0);
            AT_ISSUE_K(j + 2);
            if (act) at_pv_half(stg + vfo, pf, O, L);
            AT_WRITE_V(j + 1);
            __syncthreads();
        }
        __syncthreads();
    } else {
        for (int j = 0; j < nt; ++j) {
            const LAS unsigned char* stg = lds + (j & 1) * AT_KST; const LAS unsigned char* pst = lds + ((j + 1) & 1) * AT_KST; const int kbase = j * 64;
            AT_ISSUE_V(j + 1);
            if (j > 0 && kbase - 64 <= qmax) at_pv_half(pst + vfo, pf, O, L);
            AT_WRITE_K(j + 1);
            __syncthreads();
            __builtin_amdgcn_s_setprio(3);
            AT_ISSUE_K(j + 2);
            if (kbase <= qmax) at_qk_half(online, stg + kfo, qf, q, q0, kbase, hh, mrun, O, L, pf);
            __builtin_amdgcn_s_setprio(3);
            AT_WRITE_V(j + 1);
            __syncthreads();
            __builtin_amdgcn_s_setprio(0);
        }
        if ((nt - 1) * 64 <= qmax) at_pv_half(lds + ((nt - 1) & 1) * AT_KST + vfo, pf, O, L);
        __syncthreads();
    }
#undef AT_ISSUE_V
#undef AT_ISSUE_K
#undef AT_WRITE_K
#undef AT_WRITE_V
    const float inv = 1.f / L[0];
    LAS float* X = (LAS float*)lds;
    if (comp == 1) {
#pragma unroll
        for (int e = 0; e < 4; ++e)
#pragma unroll
            for (int i = 0; i < 16; ++i) X[(qt * 128 + 32 * e + (i & 3) + 8 * (i >> 2) + 4 * hh) * 32 + r] = O[e][i] * inv;
    }
    __syncthreads();
    if (comp == 0) {
        float ss = 0.f;
#pragma unroll
        for (int e = 0; e < 4; ++e)
#pragma unroll
            for (int i = 0; i < 16; ++i) { const float o = O[e][i] * inv - lam * X[(qt * 128 + 32 * e + (i & 3) + 8 * (i >> 2) + 4 * hh) * 32 + r]; O[e][i] = o; ss += o * o; }
        ss = half_swap_sum(ss);
        const float rn = __builtin_amdgcn_rsqf(ss * (1.f / 128.f) + EPS) * omli;
        bf16_t* ap = aout + (size_t)q * 1024 + head * 128 + 4 * hh;
#pragma unroll
        for (int e = 0; e < 4; ++e)
#pragma unroll
            for (int g4 = 0; g4 < 4; ++g4) { const int e0 = 32 * e + 8 * g4; const f32x4 sg = *(const f32x4*)(subg + e0 + 4 * hh);
                u32x2 w; w.x = pk2(O[e][4 * g4 + 0] * rn * sg[0], O[e][4 * g4 + 1] * rn * sg[1]); w.y = pk2(O[e][4 * g4 + 2] * rn * sg[2], O[e][4 * g4 + 3] * rn * sg[3]);
                *(u32x2*)(ap + e0) = w; }
    }
    __syncthreads();
}

__device__ __forceinline__ void attn_phase(LAS unsigned char* lds, const bf16_t* Q, const bf16_t* Kb, const bf16_t* VT, bf16_t* aout, const float* subg, const float* lp, const float* kgain, float lam_init) {
    int tid_ = threadIdx.x; asm volatile("" : "+v"(tid_));
    const int lane = tid_ & 63;
    const float d01 = wave_sum(lp[lane] * lp[64 + lane]), d23 = wave_sum(lp[128 + lane] * lp[192 + lane]);
    const float lam = __expf(d01) - __expf(d23) + lam_init, omli = 1.f - lam_init;
    float kg = fabsf(kgain[lane]);
#pragma unroll
    for (int o = 1; o < 64; o <<= 1) kg = fmaxf(kg, __shfl_xor(kg, o));
    const float kbound = 8.f * kg * 1.0079f;
    for (int it = blockIdx.x; it < 256; it += gridDim.x) {
        const int head = (it & 7) >> 1, pi = ((it >> 3) << 1) | (it & 1);
        attn_item(lds, Q, Kb, VT, aout, subg, lam, omli, kbound, head, 127 - pi);
        attn_item(lds, Q, Kb, VT, aout, subg, lam, omli, kbound, head, pi);
    }
}


#define XB_TMO      128
#define XB_XCNT(j)  (256  + 64 * (j))
#define XB_XSUB(j)  (1280 + 64 * (j))
#define XB_XGEN(j)  (2304 + 64 * (j))
#define XB_TOP      3328
#define XB_TOPGEN   3392
#define XCD_BAR_WORDS 3456
#define XB_SPIN_CAP (1u << 18)
__device__ __forceinline__ unsigned xb_ld(unsigned* p)              { return __hip_atomic_load(p, __ATOMIC_RELAXED, __HIP_MEMORY_SCOPE_AGENT); }
__device__ __forceinline__ unsigned xb_add(unsigned* p, unsigned v) { return __hip_atomic_fetch_add(p, v, __ATOMIC_RELAXED, __HIP_MEMORY_SCOPE_AGENT); }
__device__ __forceinline__ unsigned xb_xcc_id() { return (unsigned)__builtin_amdgcn_s_getreg((3 << 11) | 20) & 0xFu; }
#define XB_SPIN(cond, bar) do { unsigned _sp = 0; while (cond) { __builtin_amdgcn_s_sleep(1); \
    if ((++_sp & 255u) == 0u) { if (xb_ld(&(bar)[XB_TMO])) break; if (_sp > XB_SPIN_CAP) { atomicAdd(&(bar)[XB_TMO], 1u); break; } } } } while (0)
struct XcdBarrier { unsigned* bar; unsigned x; volatile LAS unsigned* st; };
__device__ __forceinline__ XcdBarrier xcd_barrier_post(unsigned* bar, volatile LAS unsigned* st) {
    XcdBarrier b; b.bar = bar; b.x = xb_xcc_id(); b.st = st;
    if (threadIdx.x == 0) (void)xb_add(&bar[XB_XCNT(b.x)], 1u);
    return b;
}
__device__ __forceinline__ void xcd_barrier_complete(unsigned* bar, unsigned x, unsigned& nloc, unsigned& nx) {
    const unsigned G = gridDim.x * gridDim.y * gridDim.z;
    unsigned sum, cnt, mine, sp = 0u;
    for (;;) {
        sum = 0u; cnt = 0u; mine = 0u;
#pragma unroll
        for (unsigned j = 0; j < 16; ++j) { const unsigned c = xb_ld(&bar[XB_XCNT(j)]); sum += c; cnt += (c > 0u) ? 1u : 0u; mine = (j == x) ? c : mine; }
        if (sum == G) break;
        __builtin_amdgcn_s_sleep(1);
        if ((++sp & 255u) == 0u) { if (xb_ld(&bar[XB_TMO])) break; if (sp > XB_SPIN_CAP) { atomicAdd(&bar[XB_TMO], 1u); break; } }
    }
    nloc = mine > 0u ? mine : 1u; nx = cnt > 0u ? cnt : 1u;
}
__device__ __forceinline__ void xcd_barrier(const XcdBarrier& b) {
    asm volatile("s_waitcnt vmcnt(0)" ::: "memory");
    __syncthreads();
    if (threadIdx.x == 0) {
        unsigned* bar = b.bar;
        __builtin_amdgcn_s_waitcnt(0);
        unsigned nloc = b.st[0], nx = b.st[1];
        if (nloc == 0u) { xcd_barrier_complete(bar, b.x, nloc, nx); b.st[0] = nloc; b.st[1] = nx; }
        const unsigned old = xb_add(&bar[XB_XSUB(b.x)], 1u);
        const unsigned gen = old / nloc;
        if (old + 1u == (gen + 1u) * nloc) {
            __builtin_amdgcn_fence(__ATOMIC_RELEASE, "agent");
            asm volatile("s_waitcnt vmcnt(0)" ::: "memory");
            const unsigned og = xb_add(&bar[XB_TOP], 1u);
            const unsigned tg = og / nx;
            if (og + 1u == (tg + 1u) * nx) xb_add(&bar[XB_TOPGEN], 1u);
            else XB_SPIN(xb_ld(&bar[XB_TOPGEN]) == tg, bar);
            __builtin_amdgcn_fence(__ATOMIC_ACQUIRE, "agent");
            xb_add(&bar[XB_XGEN(b.x)], 1u);
            asm volatile("s_waitcnt vmcnt(0)" ::: "memory");
        } else {
            XB_SPIN(xb_ld(&bar[XB_XGEN(b.x)]) == gen, bar);
            __builtin_amdgcn_fence(__ATOMIC_ACQUIRE, "agent");
            asm volatile("s_waitcnt vmcnt(0)" ::: "memory");
        }
    }
    __syncthreads();
}

__global__ void __launch_bounds__(512, 2) mk_fwd(Params p) {
    extern __shared__ __attribute__((aligned(16))) unsigned char lds_raw[];
    LAS unsigned char* lds = (LAS unsigned char*)lds_raw;
    cg::grid_group grid = cg::this_grid();
#define FRESH() int G = gridDim.x, bid = blockIdx.x; size_t wz_ = 0; asm volatile("" : "+s"(G), "+s"(bid), "+s"(wz_)); unsigned char* ws = p.ws + wz_
    XcdBarrier gbar;
    { FRESH(); (void)G;
      unsigned* barw = (unsigned*)(ws + WS_BAR);
      volatile LAS unsigned* bst = (volatile LAS unsigned*)(lds + 131072);
      if (threadIdx.x < 2) bst[threadIdx.x] = 0u;
      if (bid == 0) for (int i = threadIdx.x; i < XCD_BAR_WORDS; i += 512) barw[i] = 0u;
      gbar.bar = barw; gbar.x = 0; gbar.st = bst; }
#pragma unroll 1
    for (int l = 0; l < DEPTH; ++l) {
        const float lam_init = 0.8f - 0.6f * __expf(-0.3f * (float)l);
        prep_phase(p, l, lds);
        if (l == 0) { grid.sync(); gbar = xcd_barrier_post(gbar.bar, gbar.st); }
        else xcd_barrier(gbar);
        {
            FRESH(); float* ssq = (float*)(ws + WS_SSQ); bf16_t* xb = (bf16_t*)(ws + WS_XB);
            pg8::Gemm g{xb, (bf16_t*)(ws + WS_WIN), S, NIN, D}; pg8::StaticOrder So; So.init(S, NIN, G, bid);
            EpiInProj E{ssq, (bf16_t*)(ws + WS_Q), (bf16_t*)(ws + WS_K), (bf16_t*)(ws + WS_XP), (bf16_t*)(ws + WS_GATES), p.q_norm_g + l * 64, p.k_norm_g + l * 64, p.b_gate + l * 2048};
            pg8::gemm_phase<EpiInProj, pg8::StaticOrder, true, true>(lds, g, So, E);
            pg8::Gemm g2{(bf16_t*)(ws + WS_WV), xb, 512, S, D}; pg8::StaticOrder So2; So2.init(512, S, G, (bid + G / 2) % G);
            EpiVT E2{ssq, (bf16_t*)(ws + WS_VT)};
            pg8::gemm_phase<EpiVT, pg8::StaticOrder, true, true>(lds, g2, So2, E2);
        }
        xcd_barrier(gbar);
        {
            FRESH(); (void)G; (void)bid;
            pool_phase((const bf16_t*)(ws + WS_XP), (bf16_t*)(ws + WS_A));
            attn_phase(lds, (const bf16_t*)(ws + WS_Q), (const bf16_t*)(ws + WS_K), (const bf16_t*)(ws + WS_VT), (bf16_t*)(ws + WS_A), p.subln_g + l * 128, p.lam_params + l * 256, p.k_norm_g + l * 64, lam_init);
        }
        xcd_barrier(gbar);
        {
            FRESH(); pg8::StaticOrder So; So.init(S, D, G, bid);
            pg8::Gemm g{(bf16_t*)(ws + WS_A), (bf16_t*)(ws + WS_WUA), S, D, D}; EpiUp E{(const bf16_t*)(ws + WS_GATES), (bf16_t*)(ws + WS_MERGED)};
            pg8::gemm_phase<EpiUp, pg8::StaticOrder, true, true>(lds, g, So, E);
        }
        xcd_barrier(gbar);
        {
            FRESH(); pg8::StaticOrder So; So.init(S, D, G, bid);
            pg8::Gemm g{(bf16_t*)(ws + WS_MERGED), (bf16_t*)(ws + WS_WO), S, D, D}; EpiResid E{l == 0 ? p.x : p.out, p.out, (bf16_t*)(ws + WS_XB), (float*)(ws + WS_SSQ)};
            pg8::gemm_phase<EpiResid, pg8::StaticOrder, true, true>(lds, g, So, E);
        }
        xcd_barrier(gbar);
        {
            FRESH(); pg8::StaticOrder So; So.init(S, FF, G, bid);
            pg8::Gemm g{(bf16_t*)(ws + WS_XB), (bf16_t*)(ws + WS_W1), S, FF, D}; EpiMlpIn E{(float*)(ws + WS_SSQ), (bf16_t*)(ws + WS_U)};
            pg8::gemm_phase<EpiMlpIn, pg8::StaticOrder, true, true>(lds, g, So, E);
        }
        xcd_barrier(gbar);
        {
            FRESH(); pg8::StaticOrder So; So.init(S, D, G, bid);
            pg8::Gemm g{(bf16_t*)(ws + WS_U), (bf16_t*)(ws + WS_W2), S, D, FF}; EpiResid E{p.out, p.out, (bf16_t*)(ws + WS_XB), (float*)(ws + WS_SSQ)};
            pg8::gemm_phase<EpiResid, pg8::StaticOrder, true, true>(lds, g, So, E);
        }
        if (l + 1 < DEPTH) xcd_barrier(gbar);
    }
#undef FRESH
}

extern "C" void kernel_launch(void* const* d_in, const int* in_sizes, int n_in, void* d_out, int out_size, void* d_ws, size_t ws_size, hipStream_t stream) {
    static int grid_blocks = 0;
    if (grid_blocks == 0) {
        if (n_in != 16 || out_size != S * D || ws_size < WS_END) { fprintf(stderr, "kernel_launch: unexpected shapes (n_in %d, out %d, ws %zu)\n", n_in, out_size, ws_size); grid_blocks = -1; return; }
        int dev = 0, cus = 0, per_cu = 0;
        hipGetDevice(&dev); hipDeviceGetAttribute(&cus, hipDeviceAttributeMultiprocessorCount, dev);
        if (hipFuncSetAttribute((const void*)mk_fwd, hipFuncAttributeMaxDynamicSharedMemorySize, LDS_BYTES) != hipSuccess) { fprintf(stderr, "kernel_launch: hipFuncSetAttribute failed\n"); grid_blocks = -1; return; }
        if (hipOccupancyMaxActiveBlocksPerMultiprocessor(&per_cu, (const void*)mk_fwd, 512, LDS_BYTES) != hipSuccess || per_cu < 1) { fprintf(stderr, "kernel_launch: occupancy query says %d blocks per CU\n", per_cu); per_cu = 1; }
        (void)hipGetLastError();
        grid_blocks = cus;
    }
    if (grid_blocks < 0) return;
    Params p{};
    const float** pp = (const float**)&p;
    for (int i = 0; i < 16; ++i) pp[i] = (const float*)d_in[i];
    p.out = (float*)d_out; p.ws = (unsigned char*)d_ws;
    void* args[] = {&p};
    hipError_t e = hipLaunchCooperativeKernel((const void*)mk_fwd, dim3(grid_blocks), dim3(512), args, LDS_BYTES, stream);
    if (e != hipSuccess) fprintf(stderr, "cooperative launch failed: %s (grid %d)\n", hipGetErrorString(e), grid_blocks);
}
```

```cpp
#include <hip/hip_runtime.h>
#include <hip/hip_cooperative_groups.h>
#include <cstdio>
#include <cstdint>
#include <cmath>
namespace cg = cooperative_groups;
namespace pg8 {
#define PG8_LAS __attribute__((address_space(3)))
typedef unsigned short bf16_t;
typedef short bf16x8 __attribute__((ext_vector_type(8)));
typedef float f32x4 __attribute__((ext_vector_type(4)));
typedef unsigned u32x4 __attribute__((ext_vector_type(4)));
constexpr int BM = 256, BK = 64, HALF = 128, HTB = HALF * BK * 2  , STAGE_BYTES = 8 * HTB, NXCD = 8, WGM = 8;

__host__ __device__ __forceinline__ int lds_byte(int r, int c) { const int st = (r >> 4) * 2 + (c >> 5), rr = r & 15, cc = c & 31, ob = rr * 64 + cc * 2; return st * 1024 + (ob ^ (((ob >> 9) & 1) << 5)); }
__host__ __device__ __forceinline__ void stage_rc(int b, int& R, int& C) { const int st = b / 1024, sb = b % 1024, swz = sb ^ (((sb >> 9) & 1) << 5); R = (st >> 1) * 16 + swz / 64; C = (st & 1) * 32 + (swz % 64) / 2; }
__host__ __device__ __forceinline__ int perm32(int rho) { const int n = rho >> 4, i = rho & 15; return 8 * (i >> 2) + 4 * n + (i & 3); }

struct Unit { int pm, pn; };
struct Gemm { const bf16_t* A; const bf16_t* Bt; int M, N, K; };

struct StaticOrder {
    int nM, nN, nwg, G, c;
    __host__ __device__ void init(int M, int N, int G_, int c_) { nM = M / BM; nN = N / BM; nwg = nM * nN; G = G_; c = c_; }
    __host__ __device__ bool next(int i, Unit& u) const {
        const long L = (long)i * G + c; if (L >= nwg) return false;
        int wgid = (int)L; { const int q = nwg / NXCD, r = nwg % NXCD, xcd = wgid % NXCD, off = wgid / NXCD; wgid = (xcd < r ? xcd * (q + 1) : r * (q + 1) + (xcd - r) * q) + off; }
        const int nig = WGM * nN, gid = wgid / nig, fm = gid * WGM, gsz = (nM - fm) < WGM ? (nM - fm) : WGM;
        u.pm = fm + ((wgid % nig) % gsz); u.pn = (wgid % nig) / gsz; return true;
    }
    __device__ __forceinline__ void a_ready(const Unit&) const {}
    __device__ __forceinline__ void done(const Unit&) const {}
};

template <class Epi, class Sched, bool ALIGN_EPI = false, bool SP2 = false>
__device__ __forceinline__ void gemm_phase(PG8_LAS unsigned char* lds, const Gemm g, const Sched& S, const Epi& E) {
    int tid_ = threadIdx.x; asm volatile("" : "+v"(tid_));
    const int tid = tid_, wid = __builtin_amdgcn_readfirstlane(tid >> 6), lane = tid & 63, wr = wid >> 2, wc = wid & 3, fr = lane & 15, fq = lane >> 4;
    const int K = g.K, nt = K / BK;
    unsigned voffA[2], voffB[2];
#pragma unroll
    for (int i = 0; i < 2; ++i) { int R, C; stage_rc(tid * 16 + i * 8192, R, C); const int Rb = Epi::PERM ? ((R & ~31) + perm32(R & 31)) : R;
        voffA[i] = (unsigned)(R * K + C) * 2u; voffB[i] = (unsigned)(Rb * K + C) * 2u; }
    const size_t kstep = (size_t)(BK * 2);
    const size_t hstep = (size_t)HALF * K * 2;
    const size_t tstep = 2 * hstep;
    const unsigned ldsw = (unsigned)wid * 1024u;
    const int aoff = lds_byte(wr * 64 + fr, fq * 8), boff = lds_byte(wc * 32 + fr, fq * 8);
#define PG8_SA(b, h) (((b) * 2 + (h)) * HTB)
#define PG8_SB(b, h) ((4 + (b) * 2 + (h)) * HTB)
#define PG8_STAGE(bufoff, gbase, voff) do { _Pragma("unroll") for (int _i = 0; _i < 2; ++_i) \
        __builtin_amdgcn_global_load_lds((const unsigned*)((const char*)(gbase) + (voff)[_i]), (PG8_LAS unsigned*)(lds + (bufoff) + ldsw + _i * 8192), 16, 0, 0); } while (0)
#define PG8_LDA(dst, b, h) do { _Pragma("unroll") for (int m = 0; m < 4; ++m) _Pragma("unroll") for (int k = 0; k < 2; ++k) dst[m][k] = *(const PG8_LAS bf16x8*)(lds + PG8_SA(b, h) + aoff + m * 2048 + k * 1024); } while (0)
#define PG8_LDB(dst, b, h) do { _Pragma("unroll") for (int n = 0; n < 2; ++n) _Pragma("unroll") for (int k = 0; k < 2; ++k) dst[n][k] = *(const PG8_LAS bf16x8*)(lds + PG8_SB(b, h) + boff + n * 2048 + k * 1024); } while (0)
#define PG8_MMA(ai, bj, At, Bt) do { __builtin_amdgcn_s_setprio(1); _Pragma("unroll") for (int m = 0; m < 4; ++m) _Pragma("unroll") for (int n = 0; n < 2; ++n) _Pragma("unroll") for (int k = 0; k < 2; ++k) \
        acc[ai][bj][m][n] = __builtin_amdgcn_mfma_f32_16x16x32_bf16(Bt[n][k], At[m][k], acc[ai][bj][m][n], 0, 0, 0); __builtin_amdgcn_s_setprio(0); } while (0)
#define PG8_WAIT_V(n) asm volatile("s_waitcnt vmcnt(" #n ")" ::: "memory")
#define PG8_WAIT_L(n) asm volatile("s_waitcnt lgkmcnt(" #n ")" ::: "memory")
#define PG8_BAR __builtin_amdgcn_s_barrier()
#define PG8_SCHED __builtin_amdgcn_sched_barrier(0)
    Unit cur, nxt; int ui = 0;
    if (!S.next(0, cur)) return;
    f32x4 acc[2][2][4][2];
#pragma unroll
    for (int a = 0; a < 2; ++a)
#pragma unroll
        for (int b = 0; b < 2; ++b)
#pragma unroll
            for (int m = 0; m < 4; ++m)
#pragma unroll
                for (int n = 0; n < 2; ++n) acc[a][b][m][n] = (f32x4){0.f, 0.f, 0.f, 0.f};
    bf16x8 At[4][2], B0[2][2], B1[2][2];
    const char* cA = (const char*)g.A + (size_t)cur.pm * tstep; const char* cB = (const char*)g.Bt + (size_t)cur.pn * tstep;
    S.a_ready(cur);
    if constexpr (SP2) {
        PG8_STAGE(PG8_SB(0, 0), cB, voffB); PG8_STAGE(PG8_SB(0, 1), cB + hstep, voffB); PG8_STAGE(PG8_SA(0, 0), cA, voffA); PG8_STAGE(PG8_SA(0, 1), cA + hstep, voffA);
        if (wr == 1) PG8_BAR;
        PG8_WAIT_V(2); PG8_BAR;
        PG8_STAGE(PG8_SB(1, 0), cB + kstep, voffB); PG8_STAGE(PG8_SA(1, 0), cA + kstep, voffA); PG8_STAGE(PG8_SB(1, 1), cB + hstep + kstep, voffB);
        PG8_WAIT_V(6); PG8_BAR;
    } else {
        PG8_STAGE(PG8_SB(0, 0), cB, voffB); PG8_STAGE(PG8_SA(0, 0), cA, voffA); PG8_STAGE(PG8_SB(0, 1), cB + hstep, voffB); PG8_STAGE(PG8_SA(0, 1), cA + hstep, voffA);
        if (wr == 1) PG8_BAR;
        PG8_WAIT_V(4); PG8_BAR;
        PG8_STAGE(PG8_SB(1, 0), cB + kstep, voffB); PG8_STAGE(PG8_SA(1, 0), cA + kstep, voffA); PG8_STAGE(PG8_SB(1, 1), cB + hstep + kstep, voffB);
        PG8_WAIT_V(6); PG8_BAR;
    }
    for (;;) {
        const bool has_next = S.next(ui + 1, nxt);
        const char* nA = has_next ? (const char*)g.A + (size_t)nxt.pm * tstep : cA; const char* nB = has_next ? (const char*)g.Bt + (size_t)nxt.pn * tstep : cB;
        for (int t = 0; t < nt; t += 2) {
            const bool last = (t == nt - 2);
            const char* a1 = cA + (size_t)(t + 1) * kstep;
            const char* a2 = last ? nA : cA + (size_t)(t + 2) * kstep; const char* b2 = last ? nB : cB + (size_t)(t + 2) * kstep;
            const char* a3 = a2 + kstep; const char* b3 = b2 + kstep;
            if (last && has_next) S.a_ready(nxt);
            if constexpr (SP2) {
            PG8_LDB(B0, 0, 0); PG8_LDB(B1, 0, 1); PG8_SCHED; PG8_LDA(At, 0, 0); PG8_STAGE(PG8_SA(1, 1), a1 + hstep, voffA);
            PG8_WAIT_V(8); PG8_WAIT_L(0); PG8_BAR; PG8_MMA(0, 0, At, B0); PG8_MMA(0, 1, At, B1); PG8_BAR; PG8_SCHED;
            PG8_LDA(At, 0, 1); PG8_STAGE(PG8_SB(0, 0), b2, voffB); PG8_STAGE(PG8_SB(0, 1), b2 + hstep, voffB); PG8_STAGE(PG8_SA(0, 0), a2, voffA);
            PG8_WAIT_V(8); PG8_WAIT_L(0); PG8_BAR; PG8_MMA(1, 0, At, B0); PG8_MMA(1, 1, At, B1); PG8_BAR; PG8_SCHED;
            PG8_LDB(B0, 1, 0); PG8_LDB(B1, 1, 1); PG8_SCHED; PG8_LDA(At, 1, 0); PG8_STAGE(PG8_SA(0, 1), a2 + hstep, voffA);
            PG8_WAIT_V(8); PG8_WAIT_L(0); PG8_BAR; PG8_MMA(0, 0, At, B0); PG8_MMA(0, 1, At, B1); PG8_BAR; PG8_SCHED;
            PG8_LDA(At, 1, 1); PG8_STAGE(PG8_SB(1, 0), b3, voffB); PG8_STAGE(PG8_SB(1, 1), b3 + hstep, voffB); PG8_STAGE(PG8_SA(1, 0), a3, voffA);
            PG8_WAIT_V(8); PG8_WAIT_L(0); PG8_BAR; PG8_MMA(1, 0, At, B0); PG8_MMA(1, 1, At, B1); PG8_BAR; PG8_SCHED;
            } else {
            PG8_LDB(B0, 0, 0); PG8_SCHED; PG8_LDA(At, 0, 0); PG8_STAGE(PG8_SA(1, 1), a1 + hstep, voffA);
            PG8_WAIT_L(8); PG8_BAR; PG8_WAIT_L(0); PG8_MMA(0, 0, At, B0); PG8_BAR; PG8_SCHED;
            PG8_LDB(B1, 0, 1); PG8_STAGE(PG8_SB(0, 0), b2, voffB);
            PG8_BAR; PG8_WAIT_L(0); PG8_MMA(0, 1, At, B1); PG8_BAR;
            PG8_LDA(At, 0, 1); PG8_STAGE(PG8_SA(0, 0), a2, voffA);
            PG8_BAR; PG8_WAIT_L(0); PG8_MMA(1, 0, At, B0); PG8_BAR; PG8_SCHED;
            PG8_STAGE(PG8_SB(0, 1), b2 + hstep, voffB);
            PG8_WAIT_V(6); PG8_BAR; PG8_MMA(1, 1, At, B1); PG8_BAR;
            PG8_LDB(B0, 1, 0); PG8_SCHED; PG8_LDA(At, 1, 0); PG8_STAGE(PG8_SA(0, 1), a2 + hstep, voffA);
            PG8_WAIT_L(8); PG8_BAR; PG8_WAIT_L(0); PG8_MMA(0, 0, At, B0); PG8_BAR; PG8_SCHED;
            PG8_LDB(B1, 1, 1); PG8_STAGE(PG8_SB(1, 0), b3, voffB);
            PG8_BAR; PG8_WAIT_L(0); PG8_MMA(0, 1, At, B1); PG8_BAR;
            PG8_LDA(At, 1, 1); PG8_STAGE(PG8_SA(1, 0), a3, voffA);
            PG8_BAR; PG8_WAIT_L(0); PG8_MMA(1, 0, At, B0); PG8_BAR; PG8_SCHED;
            PG8_STAGE(PG8_SB(1, 1), b3 + hstep, voffB);
            PG8_WAIT_V(6); PG8_BAR; PG8_MMA(1, 1, At, B1); PG8_BAR;
            }
            if constexpr (Epi::MID_HOOK) { if (t == Epi::MID_T) E.mid(acc, cur, wr, wc, fr, fq); }
        }
        if constexpr (ALIGN_EPI) { if (wr == 0) PG8_BAR; }
        if constexpr (!Epi::AFTER_DRAIN) { E(acc, cur, wr, wc, fr, fq); S.done(cur); }
        if (!has_next) break;
#pragma unroll
        for (int a = 0; a < 2; ++a)
#pragma unroll
            for (int b = 0; b < 2; ++b)
#pragma unroll
                for (int m = 0; m < 4; ++m)
#pragma unroll
                    for (int n = 0; n < 2; ++n) acc[a][b][m][n] = (f32x4){0.f, 0.f, 0.f, 0.f};
        cur = nxt; cA = nA; cB = nB; ++ui;
        if constexpr (ALIGN_EPI) { if (wr == 1) PG8_BAR; }
    }
    PG8_WAIT_V(0);
    if constexpr (!ALIGN_EPI) { if (wr == 0) PG8_BAR; }
    PG8_BAR;
    if constexpr (Epi::AFTER_DRAIN) { E.fused(acc, cur, wr, wc, fr, fq, lds, wid, lane); S.done(cur); }
#undef PG8_SA
#undef PG8_SB
#undef PG8_STAGE
#undef PG8_LDA
#undef PG8_LDB
#undef PG8_MMA
#undef PG8_WAIT_V
#undef PG8_WAIT_L
#undef PG8_BAR
#undef PG8_SCHED
}
}
#define LAS __attribute__((address_space(3)))
typedef unsigned short bf16_t;
typedef short bf16x8 __attribute__((ext_vector_type(8)));
typedef float f32x4 __attribute__((ext_vector_type(4)));
typedef float f32x2 __attribute__((ext_vector_type(2)));
typedef float f32x16 __attribute__((ext_vector_type(16)));
typedef unsigned u32x4 __attribute__((ext_vector_type(4)));
typedef unsigned u32x2 __attribute__((ext_vector_type(2)));
typedef __bf16 bf16x2_t __attribute__((ext_vector_type(2)));

constexpr int S = 16384, D = 1024, DEPTH = 4, NIN = 3584  , FF = 4096;
constexpr float EPS = 1e-6f;
constexpr float QSCALE = 0.125f * 1.4426950408889634f;
constexpr float LOG2E = 1.4426950408889634f;

__device__ __forceinline__ unsigned pk2(float lo, float hi) { f32x2 v = {lo, hi}; bf16x2_t b = __builtin_convertvector(v, bf16x2_t); return __builtin_bit_cast(unsigned, b); }
__device__ __forceinline__ float bf2f(bf16_t v) { return __uint_as_float(((unsigned)v) << 16); }
__device__ __forceinline__ bf16_t f2bf(float f) { return (bf16_t)(pk2(f, 0.f) & 0xffffu); }
__device__ __forceinline__ float wave_sum(float v) {
#pragma unroll
    for (int o = 1; o < 64; o <<= 1) v += __shfl_xor(v, o);
    return v;
}
__device__ __forceinline__ float half_swap_sum(float v) { auto rr = __builtin_amdgcn_permlane32_swap(__float_as_uint(v), __float_as_uint(v), false, false); return __uint_as_float(rr[0]) + __uint_as_float(rr[1]); }
__device__ __forceinline__ float half_swap_max(float v) { auto rr = __builtin_amdgcn_permlane32_swap(__float_as_uint(v), __float_as_uint(v), false, false); return fmaxf(__uint_as_float(rr[0]), __uint_as_float(rr[1])); }

__device__ __forceinline__ float row_rstd(const float* ssq, int row) {
    const f32x4* p = (const f32x4*)(ssq + (size_t)row * 16);
    const f32x4 a = p[0], b = p[1], c = p[2], d = p[3];
    const f32x4 s = (a + b) + (c + d);
    const float t = (s[0] + s[1]) + (s[2] + s[3]);
    return __builtin_amdgcn_rsqf(t * (1.f / 1024.f) + EPS);
}

using pg8::Unit;
typedef f32x4 acc_t[2][2][4][2];

struct EpiInProj {
    static constexpr bool PERM = true, AFTER_DRAIN = false, MID_HOOK = false; static constexpr int MID_T = -1;
    const float* ssq; bf16_t* Q; bf16_t* Kb; bf16_t* xp; bf16_t* gates; const float* qg; const float* kg; const float* bg;
    __device__ __forceinline__ void operator()(const acc_t& acc, const Unit& u, int wr, int wc, int fr, int fq) const {
        const int row0 = u.pm * 256 + wr * 64 + fr, pn = u.pn;
        if (pn < 4) {
            const bool isq = pn < 2; const float* g = isq ? qg : kg; const float sc = isq ? QSCALE : 1.f;
            bf16_t* base = (isq ? Q : Kb) + (size_t)((pn & 1) * 4 + wc) * S * 64;
            f32x4 gv[2][2];
#pragma unroll
            for (int bj = 0; bj < 2; ++bj)
#pragma unroll
                for (int n = 0; n < 2; ++n) gv[bj][n] = *(const f32x4*)(g + 32 * bj + 8 * fq + 4 * n) * sc;
#pragma unroll
            for (int ai = 0; ai < 2; ++ai)
#pragma unroll
                for (int m = 0; m < 4; ++m) {
                    const int row = row0 + ai * 128 + m * 16; const float rs = row_rstd(ssq, row);
                    f32x4 v[2][2]; float ss = 0.f;
#pragma unroll
                    for (int bj = 0; bj < 2; ++bj)
#pragma unroll
                        for (int n = 0; n < 2; ++n) { v[bj][n] = acc[ai][bj][m][n] * rs; const f32x4 q2 = v[bj][n] * v[bj][n]; ss += (q2[0] + q2[1]) + (q2[2] + q2[3]); }
                    ss += __shfl_xor(ss, 16); ss += __shfl_xor(ss, 32);
                    const float r2 = __builtin_amdgcn_rsqf(ss * (1.f / 64.f) + EPS);
#pragma unroll
                    for (int bj = 0; bj < 2; ++bj) { const f32x4 a = v[bj][0] * r2 * gv[bj][0], b = v[bj][1] * r2 * gv[bj][1];
                        u32x4 w; w.x = pk2(a[0], a[1]); w.y = pk2(a[2], a[3]); w.z = pk2(b[0], b[1]); w.w = pk2(b[2], b[3]);
                        *(u32x4*)(base + (size_t)row * 64 + 32 * bj + 8 * fq) = w; }
                }
        } else if (pn < 6) {
            const int col0 = (pn - 4) * 256 + wc * 32 + 8 * fq;
#pragma unroll
            for (int ai = 0; ai < 2; ++ai)
#pragma unroll
                for (int m = 0; m < 4; ++m) {
                    const int row = row0 + ai * 128 + m * 16; const float rs = row_rstd(ssq, row);
#pragma unroll
                    for (int bj = 0; bj < 2; ++bj) { const f32x4 a = acc[ai][bj][m][0] * rs, b = acc[ai][bj][m][1] * rs;
                        u32x4 w; w.x = pk2(a[0], a[1]); w.y = pk2(a[2], a[3]); w.z = pk2(b[0], b[1]); w.w = pk2(b[2], b[3]);
                        *(u32x4*)(xp + (size_t)row * 512 + col0 + bj * 128) = w; }
                }
        } else {
            const int col0 = (pn - 6) * 256 + wc * 32 + 8 * fq;
            f32x4 bv[2][2];
#pragma unroll
            for (int bj = 0; bj < 2; ++bj)
#pragma unroll
                for (int n = 0; n < 2; ++n) bv[bj][n] = *(const f32x4*)(bg + col0 + bj * 128 + 4 * n) * (-LOG2E);
#pragma unroll
            for (int ai = 0; ai < 2; ++ai)
#pragma unroll
                for (int m = 0; m < 4; ++m) {
                    const int row = row0 + ai * 128 + m * 16; const float rs = row_rstd(ssq, row) * (-LOG2E);
#pragma unroll
                    for (int bj = 0; bj < 2; ++bj) { f32x4 a = acc[ai][bj][m][0] * rs + bv[bj][0], b = acc[ai][bj][m][1] * rs + bv[bj][1];
#pragma unroll
                        for (int j = 0; j < 4; ++j) { a[j] = __builtin_amdgcn_rcpf(1.f + __builtin_amdgcn_exp2f(a[j])); b[j] = __builtin_amdgcn_rcpf(1.f + __builtin_amdgcn_exp2f(b[j])); }
                        u32x4 w; w.x = pk2(a[0], a[1]); w.y = pk2(a[2], a[3]); w.z = pk2(b[0], b[1]); w.w = pk2(b[2], b[3]);
                        *(u32x4*)(gates + (size_t)row * 2048 + col0 + bj * 128) = w; }
                }
        }
    }
};

struct EpiVT {
    static constexpr bool PERM = false, AFTER_DRAIN = false, MID_HOOK = false; static constexpr int MID_T = -1;
    const float* ssq; bf16_t* VT;
    __device__ __forceinline__ void operator()(const acc_t& acc, const Unit& u, int wr, int wc, int fr, int fq) const {
        const int f0 = u.pm * 256 + wr * 64 + fr; const int sfq = ((fq & 1) << 1) | (fq >> 1);
#pragma unroll
        for (int bj = 0; bj < 2; ++bj)
#pragma unroll
            for (int n = 0; n < 2; ++n) {
                const int tg = u.pn * 256 + bj * 128 + wc * 32 + n * 16; const int tok = tg + 4 * fq;
                f32x4 rs; rs[0] = row_rstd(ssq, tok); rs[1] = row_rstd(ssq, tok + 1); rs[2] = row_rstd(ssq, tok + 2); rs[3] = row_rstd(ssq, tok + 3);
#pragma unroll
                for (int ai = 0; ai < 2; ++ai)
#pragma unroll
                    for (int m = 0; m < 4; ++m) { const f32x4 v = acc[ai][bj][m][n] * rs; u32x2 w; w.x = pk2(v[0], v[1]); w.y = pk2(v[2], v[3]);
                        const int f = f0 + ai * 128 + m * 16;
                        *(u32x2*)(VT + ((size_t)((f >> 7) * 256 + (tg >> 6)) * 128 + (f & 127)) * 64 + (tg & 63) + 4 * sfq) = w; }
            }
    }
};

struct EpiUp {
    static constexpr bool PERM = true, AFTER_DRAIN = false, MID_HOOK = true; static constexpr int MID_T = 6;
    const bf16_t* gates; bf16_t* merged;
    static __device__ __forceinline__ void unpack8(const u32x4 w, f32x4& a, f32x4& b) {
        a[0] = __uint_as_float(w.x << 16); a[1] = __uint_as_float(w.x & 0xffff0000u); a[2] = __uint_as_float(w.y << 16); a[3] = __uint_as_float(w.y & 0xffff0000u);
        b[0] = __uint_as_float(w.z << 16); b[1] = __uint_as_float(w.z & 0xffff0000u); b[2] = __uint_as_float(w.w << 16); b[3] = __uint_as_float(w.w & 0xffff0000u);
    }
    __device__ __forceinline__ void mid(acc_t& acc, const Unit& u, int, int, int, int) const {
        int tid = threadIdx.x; asm volatile("" : "+v"(tid));
        const int wid = tid >> 6, lane = tid & 63, wr = wid >> 2, wc = wid & 3, fr = lane & 15, fq = lane >> 4;
        const int row0 = u.pm * 256 + wr * 64 + fr, col0 = u.pn * 256 + wc * 32 + 8 * fq;
#pragma unroll
        for (int ai = 0; ai < 2; ++ai)
#pragma unroll
            for (int m = 0; m < 4; ++m) { const bf16_t* gr = gates + (size_t)(row0 + ai * 128 + m * 16) * 2048 + col0;
#pragma unroll
                for (int bj = 0; bj < 2; ++bj) { f32x4 a0, a1, b0, b1; unpack8(*(const u32x4*)(gr + bj * 128), a0, a1); unpack8(*(const u32x4*)(gr + 1024 + bj * 128), b0, b1);
#pragma unroll
                    for (int j = 0; j < 4; ++j) { a0[j] *= __builtin_amdgcn_rcpf(fmaxf(b0[j], 1e-20f)); a1[j] *= __builtin_amdgcn_rcpf(fmaxf(b1[j], 1e-20f)); }
                    acc[ai][bj][m][0] *= a0; acc[ai][bj][m][1] *= a1; }
                asm volatile("" ::: "memory"); }
    }
    __device__ __forceinline__ void operator()(const acc_t& acc, const Unit& u, int wr, int wc, int fr, int fq) const {
        const int row0 = u.pm * 256 + wr * 64 + fr, col0 = u.pn * 256 + wc * 32 + 8 * fq;
#pragma unroll
        for (int ai = 0; ai < 2; ++ai)
#pragma unroll
            for (int m = 0; m < 4; ++m) { const int row = row0 + ai * 128 + m * 16; const bf16_t* gr = gates + (size_t)row * 2048 + 1024 + col0;
#pragma unroll
                for (int bj = 0; bj < 2; ++bj) { f32x4 b0, b1; unpack8(*(const u32x4*)(gr + bj * 128), b0, b1);
#pragma unroll
                    for (int j = 0; j < 4; ++j) { b0[j] = fmaxf(b0[j], 1e-20f); b1[j] = fmaxf(b1[j], 1e-20f); }
                    const f32x4 a = acc[ai][bj][m][0] * b0, b = acc[ai][bj][m][1] * b1;
                    u32x4 w; w.x = pk2(a[0], a[1]); w.y = pk2(a[2], a[3]); w.z = pk2(b[0], b[1]); w.w = pk2(b[2], b[3]);
                    *(u32x4*)(merged + (size_t)row * 1024 + col0 + bj * 128) = w; } }
    }
};
struct EpiResid {
    static constexpr bool PERM = false, AFTER_DRAIN = false, MID_HOOK = false; static constexpr int MID_T = -1;
    const float* xin; float* xout; bf16_t* xb; float* ssq;
    __device__ __forceinline__ void operator()(const acc_t& acc, const Unit& u, int wr, int wc, int fr, int fq) const {
        const int row0 = u.pm * 256 + wr * 64 + fr, col0 = u.pn * 256 + wc * 32 + 4 * fq;
#pragma unroll
        for (int ai = 0; ai < 2; ++ai) {
            f32x4 xv[4][2][2];
#pragma unroll
            for (int m = 0; m < 4; ++m)
#pragma unroll
                for (int bj = 0; bj < 2; ++bj)
#pragma unroll
                    for (int n = 0; n < 2; ++n) xv[m][bj][n] = *(const f32x4*)(xin + (size_t)(row0 + ai * 128 + m * 16) * 1024 + col0 + bj * 128 + n * 16);
#pragma unroll
            for (int m = 0; m < 4; ++m) { const int row = row0 + ai * 128 + m * 16; float ss = 0.f;
#pragma unroll
                for (int bj = 0; bj < 2; ++bj)
#pragma unroll
                    for (int n = 0; n < 2; ++n) { const size_t off = (size_t)row * 1024 + col0 + bj * 128 + n * 16;
                        const f32x4 v = xv[m][bj][n] + acc[ai][bj][m][n];
                        *(f32x4*)(xout + off) = v; u32x2 w; w.x = pk2(v[0], v[1]); w.y = pk2(v[2], v[3]); *(u32x2*)(xb + off) = w;
                        const f32x4 q2 = v * v; ss += (q2[0] + q2[1]) + (q2[2] + q2[3]); }
                ss += __shfl_xor(ss, 16); ss += __shfl_xor(ss, 32);
                if (fq == 0) ssq[(size_t)row * 16 + u.pn * 4 + wc] = ss; }
        }
    }
};
struct EpiMlpIn {
    static constexpr bool PERM = true, AFTER_DRAIN = false, MID_HOOK = false; static constexpr int MID_T = -1;
    const float* ssq; bf16_t* U;
    __device__ __forceinline__ void operator()(const acc_t& acc, const Unit& u, int wr, int wc, int fr, int fq) const {
        const int row0 = u.pm * 256 + wr * 64 + fr, col0 = u.pn * 256 + wc * 32 + 8 * fq;
#pragma unroll
        for (int ai = 0; ai < 2; ++ai)
#pragma unroll
            for (int m = 0; m < 4; ++m) { const int row = row0 + ai * 128 + m * 16; const float rs = row_rstd(ssq, row);
#pragma unroll
                for (int bj = 0; bj < 2; ++bj) { f32x4 a = acc[ai][bj][m][0] * rs, b = acc[ai][bj][m][1] * rs;
#pragma unroll
                    for (int j = 0; j < 4; ++j) { a[j] = fmaxf(a[j], 0.f); a[j] *= a[j]; b[j] = fmaxf(b[j], 0.f); b[j] *= b[j]; }
                    u32x4 w; w.x = pk2(a[0], a[1]); w.y = pk2(a[2], a[3]); w.z = pk2(b[0], b[1]); w.w = pk2(b[2], b[3]);
                    *(u32x4*)(U + (size_t)row * FF + col0 + bj * 128) = w; } }
    }
};
constexpr size_t MiB = 1u << 20;
constexpr size_t WS_SSQ = 0;
constexpr size_t WS_WIN = 1 * MiB, WS_WV = 8 * MiB, WS_WUA = 9 * MiB, WS_WPP = 10 * MiB, WS_WO = 11 * MiB, WS_W1 = 13 * MiB, WS_W2 = 21 * MiB;
constexpr size_t WS_BAR = 29 * MiB;
constexpr size_t WS_XB = 32 * MiB;
constexpr size_t WS_Q = 64 * MiB, WS_K = 80 * MiB, WS_VT = 96 * MiB, WS_XP = 112 * MiB, WS_GATES = 128 * MiB;
constexpr size_t WS_U = 64 * MiB;
constexpr size_t WS_A = 192 * MiB  , WS_MERGED = 224 * MiB, WS_END = 256 * MiB;
constexpr int LDS_BYTES = 131072 + 1024;

__device__ __forceinline__ void transpose_item(const float* W, int ldw, int Kd, const float* gk, bf16_t* WTrow0, int k0, int n0, LAS float* scr, int lane) {
    float tv[32];
#pragma unroll
    for (int i = 0; i < 32; ++i) tv[i] = W[(size_t)(k0 + 2 * i + (lane >> 5)) * ldw + n0 + (lane & 31)];
    if (gk) {
        float gvv[32];
#pragma unroll
        for (int i = 0; i < 32; ++i) gvv[i] = gk[k0 + 2 * i + (lane >> 5)];
#pragma unroll
        for (int i = 0; i < 32; ++i) tv[i] *= gvv[i];
    }
#pragma unroll
    for (int i = 0; i < 32; ++i) scr[(2 * i + (lane >> 5)) * 33 + (lane & 31)] = tv[i];
    asm volatile("s_waitcnt lgkmcnt(0)" ::: "memory");
    const int c = lane & 7;
#pragma unroll
    for (int j = 0; j < 4; ++j) { const int n = (lane >> 3) + 8 * j; const LAS float* s = scr + (8 * c) * 33 + n;
        u32x4 o; o.x = pk2(s[0 * 33], s[1 * 33]); o.y = pk2(s[2 * 33], s[3 * 33]); o.z = pk2(s[4 * 33], s[5 * 33]); o.w = pk2(s[6 * 33], s[7 * 33]);
        *(u32x4*)(WTrow0 + (size_t)n * Kd + k0 + 8 * c) = o; }
    asm volatile("s_waitcnt lgkmcnt(0)" ::: "memory");
}

struct Params {
    const float *x, *norm1_g, *w_in, *b_gate, *q_norm_g, *k_norm_g, *lam_params, *subln_g, *pool_w, *pool_scale, *w_up_attn, *w_up_pool, *w_o, *norm2_g, *w_mlp_in, *w_mlp_out;
    float* out; unsigned char* ws;
};

__device__ __forceinline__ void prep_phase(const Params& p, int l, LAS unsigned char* lds) {
    int tid_ = threadIdx.x; asm volatile("" : "+v"(tid_));
    const int lane = tid_ & 63, wave = __builtin_amdgcn_readfirstlane(tid_ >> 6);
    LAS float* scr = (LAS float*)(lds + wave * 16384);
    const int gw = blockIdx.x * 8 + wave, NGW = gridDim.x * 8;
    unsigned char* ws = p.ws;
    bf16_t* WinT = (bf16_t*)(ws + WS_WIN); bf16_t* WvT = (bf16_t*)(ws + WS_WV); bf16_t* WuaT = (bf16_t*)(ws + WS_WUA);
    bf16_t* WoT = (bf16_t*)(ws + WS_WO); bf16_t* W1T = (bf16_t*)(ws + WS_W1); bf16_t* W2T = (bf16_t*)(ws + WS_W2);
    const float* w_in = p.w_in + (size_t)l * D * 4096; const float* g1 = p.norm1_g + l * D; const float* g2 = p.norm2_g + l * D;
    const float* wua = p.w_up_attn + (size_t)l * 512 * D; const float* wup = p.w_up_pool + (size_t)l * 512 * D; const float* wo = p.w_o + (size_t)l * D * D;
    const float* w1 = p.w_mlp_in + (size_t)l * D * FF; const float* w2 = p.w_mlp_out + (size_t)l * FF * D;
    const float* pw = p.pool_w + (size_t)l * 4 * 128 * 128; const float* ps = p.pool_scale + l * 512;
    constexpr int I_PP = 2048, I_IN = 16 * 128, I_UA = 8 * 32, I_O = 16 * 32, I_1 = 16 * 128, I_2 = 64 * 32;
    constexpr int NITEMS = I_PP + I_IN + I_UA + I_O + I_1 + I_2;
    for (int it = gw; it < NITEMS; it += NGW) {
        int r = it;
        if (r < I_PP) {
            const int g = r >> 9, d0 = ((r >> 1) & 255) * 4, cblk = r & 1; const int c = cblk * 64 + lane;
            const float* pwr = pw + (size_t)(g * 128 + c) * 128; const float* psg = ps + g * 128; const float* wu = wup + (size_t)(g * 128) * D + d0;
            f32x4 pwv[32];
#pragma unroll
            for (int jj = 0; jj < 32; ++jj) pwv[jj] = *(const f32x4*)(pwr + 4 * jj);
#pragma unroll
            for (int i = 0; i < 8; ++i) { const int idx = i * 64 + lane; scr[idx] = wu[(size_t)(idx >> 2) * D + (idx & 3)]; }
            asm volatile("s_waitcnt lgkmcnt(0)" ::: "memory");
            f32x4 acc = {0.f, 0.f, 0.f, 0.f};
#pragma unroll
            for (int jj = 0; jj < 32; ++jj) { const f32x4 a4 = pwv[jj] * *(const f32x4*)(psg + 4 * jj);
#pragma unroll
                for (int t = 0; t < 4; ++t) acc += *(const LAS f32x4*)(scr + (4 * jj + t) * 4) * a4[t]; }
#pragma unroll
            for (int dd = 0; dd < 4; ++dd) WuaT[(size_t)(d0 + dd) * 1024 + 512 + g * 128 + c] = f2bf(acc[dd]);
            asm volatile("s_waitcnt lgkmcnt(0)" ::: "memory");
            continue;
        }
        r -= I_PP;
        if (r < I_IN) { const int kb = r >> 7, nb = r & 127, n0 = nb * 32; bf16_t* dst;
            if (n0 < 1024) dst = WinT + (size_t)((n0 & ~255) + 128 * ((n0 >> 5) & 1) + 32 * ((n0 >> 6) & 3)) * D;
            else if (n0 < 1536) dst = WvT + (size_t)(n0 - 1024) * D;
            else dst = WinT + (size_t)(n0 - 512) * D;
            transpose_item(w_in, 4096, D, g1, dst, kb * 64, n0, scr, lane); continue; }
        r -= I_IN;
        if (r < I_UA) { const int kb = r >> 5, nb = r & 31; transpose_item(wua, D, 1024, nullptr, WuaT + (size_t)(nb * 32) * 1024, kb * 64, nb * 32, scr, lane); continue; }
        r -= I_UA;
        if (r < I_O) { const int kb = r >> 5, nb = r & 31; transpose_item(wo, D, D, nullptr, WoT + (size_t)(nb * 32) * D, kb * 64, nb * 32, scr, lane); continue; }
        r -= I_O;
        if (r < I_1) { const int kb = r >> 7, nb = r & 127; transpose_item(w1, FF, D, g2, W1T + (size_t)(nb * 32) * D, kb * 64, nb * 32, scr, lane); continue; }
        r -= I_1;
        { const int kb = r >> 5, nb = r & 31; transpose_item(w2, D, FF, nullptr, W2T + (size_t)(nb * 32) * FF, kb * 64, nb * 32, scr, lane); }
    }
    if (l == 0) {
        bf16_t* xb = (bf16_t*)(ws + WS_XB); float* ssq = (float*)(ws + WS_SSQ);
        for (int m = gw; m < S; m += NGW) {
            const f32x4* xr = (const f32x4*)(p.x + (size_t)m * D) + lane; u32x2* o8 = (u32x2*)(xb + (size_t)m * D) + lane; float s = 0.f;
#pragma unroll
            for (int j = 0; j < 4; ++j) { const f32x4 v = xr[64 * j]; s += (v[0] * v[0] + v[1] * v[1]) + (v[2] * v[2] + v[3] * v[3]); u32x2 w; w.x = pk2(v[0], v[1]); w.y = pk2(v[2], v[3]); o8[64 * j] = w; }
            s = wave_sum(s);
            if (lane < 16) ssq[(size_t)m * 16 + lane] = lane == 0 ? s : 0.f;
        }
    }
}

template <int W> __device__ __forceinline__ void pool_tile(const bf16_t* xp, bf16_t* pooled, int t0, int ch0) {
    u32x4 prev[W], cur[8];
#pragma unroll
    for (int k = 0; k < W; ++k) { const int t = t0 - W + k; prev[k] = t >= 0 ? *(const u32x4*)(xp + (size_t)t * 512 + ch0) : (u32x4){0u, 0u, 0u, 0u}; }
#pragma unroll
    for (int i = 0; i < 8; ++i) cur[i] = *(const u32x4*)(xp + (size_t)(t0 + i) * 512 + ch0);
    float s[8];
#pragma unroll
    for (int c = 0; c < 8; ++c) s[c] = 0.f;
#pragma unroll
    for (int k = 0; k < W; ++k)
#pragma unroll
        for (int c = 0; c < 4; ++c) { s[2 * c] += __uint_as_float(prev[k][c] << 16); s[2 * c + 1] += __uint_as_float(prev[k][c] & 0xffff0000u); }
#pragma unroll
    for (int i = 0; i < 8; ++i) {
        const u32x4 old = i < W ? prev[i < W ? i : 0] : cur[i >= W ? i - W : 0];
        const int t = t0 + i; const float cnt = (float)(t + 1 < W ? t + 1 : W);
        u32x4 o;
#pragma unroll
        for (int c = 0; c < 4; ++c) {
            const float c0 = __uint_as_float(cur[i][c] << 16), c1 = __uint_as_float(cur[i][c] & 0xffff0000u);
            s[2 * c] += c0 - __uint_as_float(old[c] << 16); s[2 * c + 1] += c1 - __uint_as_float(old[c] & 0xffff0000u);
            o[c] = pk2(s[2 * c] / cnt - c0, s[2 * c + 1] / cnt - c1);
        }
        *(u32x4*)(pooled + (size_t)t * 1024 + 512 + ch0) = o;
    }
}
__device__ __forceinline__ void pool_phase(const bf16_t* xp, bf16_t* pooled) {
    int tid_ = threadIdx.x; asm volatile("" : "+v"(tid_));
    const int lane = tid_ & 63, wave = __builtin_amdgcn_readfirstlane(tid_ >> 6);
    const int g = wave & 3, ch0 = g * 128 + (lane & 15) * 8, tsub = (wave >> 2) * 32 + (lane >> 4) * 8;
    for (int chunk = blockIdx.x; chunk < S / 64; chunk += gridDim.x) {
        const int t0 = chunk * 64 + tsub;
        if (g == 0) pool_tile<2>(xp, pooled, t0, ch0); else if (g == 1) pool_tile<4>(xp, pooled, t0, ch0); else if (g == 2) pool_tile<8>(xp, pooled, t0, ch0); else pool_tile<16>(xp, pooled, t0, ch0);
    }
}

constexpr int AT_ROWB = 144, AT_K2 = 64 * AT_ROWB, AT_KST = 2 * AT_K2  , AT_VST = 128 * AT_ROWB  , AT_VOFF = 2 * AT_KST;
#define MFMA32(a, b, c) __builtin_amdgcn_mfma_f32_32x32x16_bf16((a), (b), (c), 0, 0, 0)

__device__ __forceinline__ float at_max3(float a, float b, float c) { float r; asm("v_max3_f32 %0, %1, %2, %3" : "=v"(r) : "v"(a), "v"(b), "v"(c)); return r; }
__device__ __forceinline__ void at_qk_half(const bool ONLINE, const LAS unsigned char* kp, const bf16x8 (&qf)[4], int q, int q0, int kbase, int hh, float& mrun, f32x16 (&O)[4], f32x16& L, bf16x8 (&pf)[4]) {
    __builtin_amdgcn_s_setprio(3);
    bf16x8 kf[8];
#pragma unroll
    for (int s = 0; s < 4; ++s) { kf[2 * s] = *(const LAS bf16x8*)(kp + 32 * s); kf[2 * s + 1] = *(const LAS bf16x8*)(kp + 32 * AT_ROWB + 32 * s); }
    __builtin_amdgcn_sched_barrier(0);
    f32x16 s0, s1;
#pragma unroll
    for (int i = 0; i < 16; ++i) { s0[i] = 0.f; s1[i] = 0.f; }
#pragma unroll
    for (int s = 0; s < 4; ++s) { s0 = MFMA32(kf[2 * s], qf[s], s0); s1 = MFMA32(kf[2 * s + 1], qf[s], s1); }
    if (kbase + 63 > q0) {
        const int kb = kbase + 4 * hh;
#pragma unroll
        for (int i = 0; i < 16; ++i) { const int kv = kb + (i & 3) + 8 * (i >> 2); if (kv > q) s0[i] = -INFINITY; if (kv + 32 > q) s1[i] = -INFINITY; }
    }
    if (ONLINE) {
#pragma unroll
        for (int i = 0; i < 16; ++i) { s0[i] -= mrun; s1[i] -= mrun; }
        float mx = fmaxf(s0[0], s1[0]);
#pragma unroll
        for (int i = 1; i < 16; ++i) mx = at_max3(mx, s0[i], s1[i]);
        mx = half_swap_max(mx);
        if (__builtin_amdgcn_ballot_w64(mx > 8.f) != 0ull) {
            const float d = fmaxf(mx, 0.f); const float alpha = __builtin_amdgcn_exp2f(-d); mrun += d;
#pragma unroll
            for (int e = 0; e < 4; ++e)
#pragma unroll
                for (int i = 0; i < 16; ++i) O[e][i] *= alpha;
#pragma unroll
            for (int i = 0; i < 16; ++i) { L[i] *= alpha; s0[i] -= d; s1[i] -= d; }
        }
    }
#pragma unroll
    for (int i = 0; i < 16; ++i) { s0[i] = __builtin_amdgcn_exp2f(s0[i]); s1[i] = __builtin_amdgcn_exp2f(s1[i]); }
#pragma unroll
    for (int s2 = 0; s2 < 2; ++s2) {
        u32x4 a, b;
        a.x = pk2(s0[8 * s2 + 0], s0[8 * s2 + 1]); a.y = pk2(s0[8 * s2 + 2], s0[8 * s2 + 3]); a.z = pk2(s0[8 * s2 + 4], s0[8 * s2 + 5]); a.w = pk2(s0[8 * s2 + 6], s0[8 * s2 + 7]);
        b.x = pk2(s1[8 * s2 + 0], s1[8 * s2 + 1]); b.y = pk2(s1[8 * s2 + 2], s1[8 * s2 + 3]); b.z = pk2(s1[8 * s2 + 4], s1[8 * s2 + 5]); b.w = pk2(s1[8 * s2 + 6], s1[8 * s2 + 7]);
        pf[s2] = __builtin_bit_cast(bf16x8, a); pf[2 + s2] = __builtin_bit_cast(bf16x8, b);
    }
    __builtin_amdgcn_s_setprio(0);
}
__device__ __forceinline__ void at_pv_half(const LAS unsigned char* vp, const bf16x8 (&pf)[4], f32x16 (&O)[4], f32x16& L) {
    bf16x8 va[8], vb[8];
#pragma unroll
    for (int e = 0; e < 2; ++e)
#pragma unroll
        for (int ks = 0; ks < 4; ++ks) va[e * 4 + ks] = *(const LAS bf16x8*)(vp + e * 32 * AT_ROWB + 32 * ks);
#pragma unroll
    for (int e = 0; e < 2; ++e)
#pragma unroll
        for (int ks = 0; ks < 4; ++ks) vb[e * 4 + ks] = *(const LAS bf16x8*)(vp + (2 + e) * 32 * AT_ROWB + 32 * ks);
    const short one = (short)0x3F80; const bf16x8 ones = {one, one, one, one, one, one, one, one};
    __builtin_amdgcn_sched_barrier(0);
#pragma unroll
    for (int ks = 0; ks < 4; ++ks) L = MFMA32(ones, pf[ks], L);
    __builtin_amdgcn_sched_barrier(0);
#pragma unroll
    for (int ks = 0; ks < 4; ++ks) { O[0] = MFMA32(va[ks], pf[ks], O[0]); O[1] = MFMA32(va[4 + ks], pf[ks], O[1]); }
#pragma unroll
    for (int ks = 0; ks < 4; ++ks) { O[2] = MFMA32(vb[ks], pf[ks], O[2]); O[3] = MFMA32(vb[4 + ks], pf[ks], O[3]); }
}

__device__ __forceinline__ void attn_item(LAS unsigned char* lds, const bf16_t* Q, const bf16_t* Kb, const bf16_t* VT, bf16_t* aout, const float* subg, float lam, float omli, float kbound, int head, int qb) {
    int tid_ = threadIdx.x; asm volatile("" : "+v"(tid_));
    const int tid = tid_, lane = tid & 63, r = lane & 31, hh = lane >> 5; const int wid = __builtin_amdgcn_readfirstlane(tid >> 6);
    const int comp = wid >> 2, qt = wid & 3; const int q0 = qb * 128 + qt * 32, q = q0 + r; const int nt = 2 * qb + 2;
    bf16x8 qf[4];
    { const bf16_t* Qp = Q + ((size_t)(head * 2 + comp) * S + q) * 64 + 8 * hh;
#pragma unroll
      for (int s = 0; s < 4; ++s) qf[s] = *(const bf16x8*)(Qp + 16 * s); }
    const int srow = tid >> 3, sch = tid & 7;
    const char* bK1 = (const char*)(Kb + (size_t)(head * 2 + 0) * S * 64); const char* bK2 = (const char*)(Kb + (size_t)(head * 2 + 1) * S * 64);
    const char* bV0 = (const char*)(VT + (size_t)head * 256 * 128 * 64); const char* bV1 = bV0 + 8192;
    const unsigned koff = srow * 128 + sch * 16, voff = koff;
    const unsigned dK1 = srow * AT_ROWB + sch * 16, dK2 = AT_K2 + dK1, dV0 = AT_VOFF + dK1, dV1 = AT_VOFF + 64 * AT_ROWB + dK1;
    u32x4 ks0 = *(const u32x4*)(bK1 + koff), ks1 = *(const u32x4*)(bK2 + koff), vs0 = *(const u32x4*)(bV0 + voff), vs1 = *(const u32x4*)(bV1 + voff);
    *(LAS u32x4*)(lds + dK1) = ks0; *(LAS u32x4*)(lds + dK2) = ks1; *(LAS u32x4*)(lds + dV0) = vs0; *(LAS u32x4*)(lds + dV1) = vs1;
    ks0 = *(const u32x4*)(bK1 + 8192 + koff); ks1 = *(const u32x4*)(bK2 + 8192 + koff);
    asm volatile("" : "+v"(qf[0]), "+v"(qf[1]), "+v"(qf[2]), "+v"(qf[3]));
    __syncthreads();
    f32x16 O[4];
#pragma unroll
    for (int e = 0; e < 4; ++e)
#pragma unroll
        for (int i = 0; i < 16; ++i) O[e][i] = 0.f;
    float qn2 = 0.f;
#pragma unroll
    for (int s = 0; s < 4; ++s)
#pragma unroll
        for (int e = 0; e < 8; ++e) { const float v = bf2f((bf16_t)qf[s][e]); qn2 += v * v; }
    const float sbound = __builtin_sqrtf(half_swap_sum(qn2)) * kbound;
    const bool online = __builtin_amdgcn_ballot_w64(!(sbound <= 100.f)) != 0ull;
    float mrun = 0.f;
    f32x16 L;
#pragma unroll
    for (int i = 0; i < 16; ++i) L[i] = 0.f;
    bf16x8 pf[4];
#pragma unroll
    for (int i = 0; i < 4; ++i) pf[i] = (bf16x8){0, 0, 0, 0, 0, 0, 0, 0};
    const unsigned kfo = comp * AT_K2 + r * AT_ROWB + 16 * hh, vfo = AT_VOFF + r * AT_ROWB + 16 * hh;
    const int qmax = q0 + 31, ntm1 = nt - 1;
#define AT_ISSUE_V(jn) do { const int jc_ = (jn) < ntm1 ? (jn) : ntm1; const size_t vo_ = (size_t)jc_ * 16384; vs0 = *(const u32x4*)(bV0 + vo_ + voff); vs1 = *(const u32x4*)(bV1 + vo_ + voff); } while (0)
#define AT_ISSUE_K(jn) do { const int jc_ = (jn) < ntm1 ? (jn) : ntm1; const size_t ko_ = (size_t)jc_ * 8192; ks0 = *(const u32x4*)(bK1 + ko_ + koff); ks1 = *(const u32x4*)(bK2 + ko_ + koff); } while (0)
#define AT_WRITE_K(jn) do { LAS unsigned char* n_ = lds + ((jn) & 1) * AT_KST; *(LAS u32x4*)(n_ + dK1) = ks0; *(LAS u32x4*)(n_ + dK2) = ks1; } while (0)
#define AT_WRITE_V(jn) do { LAS unsigned char* n_ = lds + ((jn) & 1) * AT_KST; *(LAS u32x4*)(n_ + dV0) = vs0; *(LAS u32x4*)(n_ + dV1) = vs1; } while (0)
    if (comp == 0) {
        for (int j = 0; j < nt; ++j) {
            const LAS unsigned char* stg = lds + (j & 1) * AT_KST; const int kbase = j * 64; const bool act = kbase <= qmax;
            __builtin_amdgcn_s_setprio(3);
            AT_ISSUE_V(j + 1);
            if (act) at_qk_half(online, stg + kfo, qf, q, q0, kbase, hh, mrun, O, L, pf);
            __builtin_amdgcn_s_setprio(3);
            AT_WRITE_K(j + 1);
            __syncthreads();
            __builtin_amdgcn_s_setprio(0);
            AT_ISSUE_K(j + 2);
            if (act) at_pv_half(stg + vfo, pf, O, L);
            AT_WRITE_V(j + 1);
            __syncthreads();
        }
        __syncthreads();
    } else {
        for (int j = 0; j < nt; ++j) {
            const LAS unsigned char* stg = lds + (j & 1) * AT_KST; const LAS unsigned char* pst = lds + ((j + 1) & 1) * AT_KST; const int kbase = j * 64;
            AT_ISSUE_V(j + 1);
            if (j > 0 && kbase - 64 <= qmax) at_pv_half(pst + vfo, pf, O, L);
            AT_WRITE_K(j + 1);
            __syncthreads();
            __builtin_amdgcn_s_setprio(3);
            AT_ISSUE_K(j + 2);
            if (kbase <= qmax) at_qk_half(online, stg + kfo, qf, q, q0, kbase, hh, mrun, O, L, pf);
            __builtin_amdgcn_s_setprio(3);
            AT_WRITE_V(j + 1);
            __syncthreads();
            __builtin_amdgcn_s_setprio(0);
        }
        if ((nt - 1) * 64 <= qmax) at_pv_half(lds + ((nt - 1) & 1) * AT_KST + vfo, pf, O, L);
        __syncthreads();
    }
#undef AT_ISSUE_V
#undef AT_ISSUE_K
#undef AT_WRITE_K
#undef AT_WRITE_V
    const float inv = 1.f / L[0];
    LAS float* X = (LAS float*)lds;
    if (comp == 1) {
#pragma unroll
        for (int e = 0; e < 4; ++e)
#pragma unroll
            for (int i = 0; i < 16; ++i) X[(qt * 128 + 32 * e + (i & 3) + 8 * (i >> 2) + 4 * hh) * 32 + r] = O[e][i] * inv;
    }
    __syncthreads();
    if (comp == 0) {
        float ss = 0.f;
#pragma unroll
        for (int e = 0; e < 4; ++e)
#pragma unroll
            for (int i = 0; i < 16; ++i) { const float o = O[e][i] * inv - lam * X[(qt * 128 + 32 * e + (i & 3) + 8 * (i >> 2) + 4 * hh) * 32 + r]; O[e][i] = o; ss += o * o; }
        ss = half_swap_sum(ss);
        const float rn = __builtin_amdgcn_rsqf(ss * (1.f / 128.f) + EPS) * omli;
        bf16_t* ap = aout + (size_t)q * 1024 + head * 128 + 4 * hh;
#pragma unroll
        for (int e = 0; e < 4; ++e)
#pragma unroll
            for (int g4 = 0; g4 < 4; ++g4) { const int e0 = 32 * e + 8 * g4; const f32x4 sg = *(const f32x4*)(subg + e0 + 4 * hh);
                u32x2 w; w.x = pk2(O[e][4 * g4 + 0] * rn * sg[0], O[e][4 * g4 + 1] * rn * sg[1]); w.y = pk2(O[e][4 * g4 + 2] * rn * sg[2], O[e][4 * g4 + 3] * rn * sg[3]);
                *(u32x2*)(ap + e0) = w; }
    }
    __syncthreads();
}

__device__ __forceinline__ void attn_phase(LAS unsigned char* lds, const bf16_t* Q, const bf16_t* Kb, const bf16_t* VT, bf16_t* aout, const float* subg, const float* lp, const float* kgain, float lam_init) {
    int tid_ = threadIdx.x; asm volatile("" : "+v"(tid_));
    const int lane = tid_ & 63;
    const float d01 = wave_sum(lp[lane] * lp[64 + lane]), d23 = wave_sum(lp[128 + lane] * lp[192 + lane]);
    const float lam = __expf(d01) - __expf(d23) + lam_init, omli = 1.f - lam_init;
    float kg = fabsf(kgain[lane]);
#pragma unroll
    for (int o = 1; o < 64; o <<= 1) kg = fmaxf(kg, __shfl_xor(kg, o));
    const float kbound = 8.f * kg * 1.0079f;
    for (int it = blockIdx.x; it < 256; it += gridDim.x) {
        const int head = (it & 7) >> 1, pi = ((it >> 3) << 1) | (it & 1);
        attn_item(lds, Q, Kb, VT, aout, subg, lam, omli, kbound, head, 127 - pi);
        attn_item(lds, Q, Kb, VT, aout, subg, lam, omli, kbound, head, pi);
    }
}


#define XB_TMO      128
#define XB_XCNT(j)  (256  + 64 * (j))
#define XB_XSUB(j)  (1280 + 64 * (j))
#define XB_XGEN(j)  (2304 + 64 * (j))
#define XB_TOP      3328
#define XB_TOPGEN   3392
#define XCD_BAR_WORDS 3456
#define XB_SPIN_CAP (1u << 18)
__device__ __forceinline__ unsigned xb_ld(unsigned* p)              { return __hip_atomic_load(p, __ATOMIC_RELAXED, __HIP_MEMORY_SCOPE_AGENT); }
__device__ __forceinline__ unsigned xb_add(unsigned* p, unsigned v) { return __hip_atomic_fetch_add(p, v, __ATOMIC_RELAXED, __HIP_MEMORY_SCOPE_AGENT); }
__device__ __forceinline__ unsigned xb_xcc_id() { return (unsigned)__builtin_amdgcn_s_getreg((3 << 11) | 20) & 0xFu; }
#define XB_SPIN(cond, bar) do { unsigned _sp = 0; while (cond) { __builtin_amdgcn_s_sleep(1); \
    if ((++_sp & 255u) == 0u) { if (xb_ld(&(bar)[XB_TMO])) break; if (_sp > XB_SPIN_CAP) { atomicAdd(&(bar)[XB_TMO], 1u); break; } } } } while (0)
struct XcdBarrier { unsigned* bar; unsigned x; volatile LAS unsigned* st; };
__device__ __forceinline__ XcdBarrier xcd_barrier_post(unsigned* bar, volatile LAS unsigned* st) {
    XcdBarrier b; b.bar = bar; b.x = xb_xcc_id(); b.st = st;
    if (threadIdx.x == 0) (void)xb_add(&bar[XB_XCNT(b.x)], 1u);
    return b;
}
__device__ __forceinline__ void xcd_barrier_complete(unsigned* bar, unsigned x, unsigned& nloc, unsigned& nx) {
    const unsigned G = gridDim.x * gridDim.y * gridDim.z;
    unsigned sum, cnt, mine, sp = 0u;
    for (;;) {
        sum = 0u; cnt = 0u; mine = 0u;
#pragma unroll
        for (unsigned j = 0; j < 16; ++j) { const unsigned c = xb_ld(&bar[XB_XCNT(j)]); sum += c; cnt += (c > 0u) ? 1u : 0u; mine = (j == x) ? c : mine; }
        if (sum == G) break;
        __builtin_amdgcn_s_sleep(1);
        if ((++sp & 255u) == 0u) { if (xb_ld(&bar[XB_TMO])) break; if (sp > XB_SPIN_CAP) { atomicAdd(&bar[XB_TMO], 1u); break; } }
    }
    nloc = mine > 0u ? mine : 1u; nx = cnt > 0u ? cnt : 1u;
}
__device__ __forceinline__ void xcd_barrier(const XcdBarrier& b) {
    asm volatile("s_waitcnt vmcnt(0)" ::: "memory");
    __syncthreads();
    if (threadIdx.x == 0) {
        unsigned* bar = b.bar;
        __builtin_amdgcn_s_waitcnt(0);
        unsigned nloc = b.st[0], nx = b.st[1];
        if (nloc == 0u) { xcd_barrier_complete(bar, b.x, nloc, nx); b.st[0] = nloc; b.st[1] = nx; }
        const unsigned old = xb_add(&bar[XB_XSUB(b.x)], 1u);
        const unsigned gen = old / nloc;
        if (old + 1u == (gen + 1u) * nloc) {
            __builtin_amdgcn_fence(__ATOMIC_RELEASE, "agent");
            asm volatile("s_waitcnt vmcnt(0)" ::: "memory");
            const unsigned og = xb_add(&bar[XB_TOP], 1u);
            const unsigned tg = og / nx;
            if (og + 1u == (tg + 1u) * nx) xb_add(&bar[XB_TOPGEN], 1u);
            else XB_SPIN(xb_ld(&bar[XB_TOPGEN]) == tg, bar);
            __builtin_amdgcn_fence(__ATOMIC_ACQUIRE, "agent");
            xb_add(&bar[XB_XGEN(b.x)], 1u);
            asm volatile("s_waitcnt vmcnt(0)" ::: "memory");
        } else {
            XB_SPIN(xb_ld(&bar[XB_XGEN(b.x)]) == gen, bar);
            __builtin_amdgcn_fence(__ATOMIC_ACQUIRE, "agent");
            asm volatile("s_waitcnt vmcnt(0)" ::: "memory");
        }
    }
    __syncthreads();
}

__global__ void __launch_bounds__(512, 2) mk_fwd(Params p) {
    extern __shared__ __attribute__((aligned(16))) unsigned char lds_raw[];
    LAS unsigned char* lds = (LAS unsigned char*)lds_raw;
    cg::grid_group grid = cg::this_grid();
#define FRESH() int G = gridDim.x, bid = blockIdx.x; size_t wz_ = 0; asm volatile("" : "+s"(G), "+s"(bid), "+s"(wz_)); unsigned char* ws = p.ws + wz_
    XcdBarrier gbar;
    { FRESH(); (void)G;
      unsigned* barw = (unsigned*)(ws + WS_BAR);
      volatile LAS unsigned* bst = (volatile LAS unsigned*)(lds + 131072);
      if (threadIdx.x < 2) bst[threadIdx.x] = 0u;
      if (bid == 0) for (int i = threadIdx.x; i < XCD_BAR_WORDS; i += 512) barw[i] = 0u;
      gbar.bar = barw; gbar.x = 0; gbar.st = bst; }
#pragma unroll 1
    for (int l = 0; l < DEPTH; ++l) {
        const float lam_init = 0.8f - 0.6f * __expf(-0.3f * (float)l);
        prep_phase(p, l, lds);
        if (l == 0) { grid.sync(); gbar = xcd_barrier_post(gbar.bar, gbar.st); }
        else xcd_barrier(gbar);
        {
            FRESH(); float* ssq = (float*)(ws + WS_SSQ); bf16_t* xb = (bf16_t*)(ws + WS_XB);
            pg8::Gemm g{xb, (bf16_t*)(ws + WS_WIN), S, NIN, D}; pg8::StaticOrder So; So.init(S, NIN, G, bid);
            EpiInProj E{ssq, (bf16_t*)(ws + WS_Q), (bf16_t*)(ws + WS_K), (bf16_t*)(ws + WS_XP), (bf16_t*)(ws + WS_GATES), p.q_norm_g + l * 64, p.k_norm_g + l * 64, p.b_gate + l * 2048};
            pg8::gemm_phase<EpiInProj, pg8::StaticOrder, true, true>(lds, g, So, E);
            pg8::Gemm g2{(bf16_t*)(ws + WS_WV), xb, 512, S, D}; pg8::StaticOrder So2; So2.init(512, S, G, (bid + G / 2) % G);
            EpiVT E2{ssq, (bf16_t*)(ws + WS_VT)};
            pg8::gemm_phase<EpiVT, pg8::StaticOrder, true, true>(lds, g2, So2, E2);
        }
        xcd_barrier(gbar);
        {
            FRESH(); (void)G; (void)bid;
            pool_phase((const bf16_t*)(ws + WS_XP), (bf16_t*)(ws + WS_A));
            attn_phase(lds, (const bf16_t*)(ws + WS_Q), (const bf16_t*)(ws + WS_K), (const bf16_t*)(ws + WS_VT), (bf16_t*)(ws + WS_A), p.subln_g + l * 128, p.lam_params + l * 256, p.k_norm_g + l * 64, lam_init);
        }
        xcd_barrier(gbar);
        {
            FRESH(); pg8::StaticOrder So; So.init(S, D, G, bid);
            pg8::Gemm g{(bf16_t*)(ws + WS_A), (bf16_t*)(ws + WS_WUA), S, D, D}; EpiUp E{(const bf16_t*)(ws + WS_GATES), (bf16_t*)(ws + WS_MERGED)};
            pg8::gemm_phase<EpiUp, pg8::StaticOrder, true, true>(lds, g, So, E);
        }
        xcd_barrier(gbar);
        {
            FRESH(); pg8::StaticOrder So; So.init(S, D, G, bid);
            pg8::Gemm g{(bf16_t*)(ws + WS_MERGED), (bf16_t*)(ws + WS_WO), S, D, D}; EpiResid E{l == 0 ? p.x : p.out, p.out, (bf16_t*)(ws + WS_XB), (float*)(ws + WS_SSQ)};
            pg8::gemm_phase<EpiResid, pg8::StaticOrder, true, true>(lds, g, So, E);
        }
        xcd_barrier(gbar);
        {
            FRESH(); pg8::StaticOrder So; So.init(S, FF, G, bid);
            pg8::Gemm g{(bf16_t*)(ws + WS_XB), (bf16_t*)(ws + WS_W1), S, FF, D}; EpiMlpIn E{(float*)(ws + WS_SSQ), (bf16_t*)(ws + WS_U)};
            pg8::gemm_phase<EpiMlpIn, pg8::StaticOrder, true, true>(lds, g, So, E);
        }
        xcd_barrier(gbar);
        {
            FRESH(); pg8::StaticOrder So; So.init(S, D, G, bid);
            pg8::Gemm g{(bf16_t*)(ws + WS_U), (bf16_t*)(ws + WS_W2), S, D, FF}; EpiResid E{p.out, p.out, (bf16_t*)(ws + WS_XB), (float*)(ws + WS_SSQ)};
            pg8::gemm_phase<EpiResid, pg8::StaticOrder, true, true>(lds, g, So, E);
        }
        if (l + 1 < DEPTH) xcd_barrier(gbar);
    }
#undef FRESH
}

extern "C" void kernel_launch(void* const* d_in, const int* in_sizes, int n_in, void* d_out, int out_size, void* d_ws, size_t ws_size, hipStream_t stream) {
    static int grid_blocks = 0;
    if (grid_blocks == 0) {
        if (n_in != 16 || out_size != S * D || ws_size < WS_END) { fprintf(stderr, "kernel_launch: unexpected shapes (n_in %d, out %d, ws %zu)\n", n_in, out_size, ws_size); grid_blocks = -1; return; }
        int dev = 0, cus = 0, per_cu = 0;
        hipGetDevice(&dev); hipDeviceGetAttribute(&cus, hipDeviceAttributeMultiprocessorCount, dev);
        if (hipFuncSetAttribute((const void*)mk_fwd, hipFuncAttributeMaxDynamicSharedMemorySize, LDS_BYTES) != hipSuccess) { fprintf(stderr, "kernel_launch: hipFuncSetAttribute failed\n"); grid_blocks = -1; return; }
        if (hipOccupancyMaxActiveBlocksPerMultiprocessor(&per_cu, (const void*)mk_fwd, 512, LDS_BYTES) != hipSuccess || per_cu < 1) { fprintf(stderr, "kernel_launch: occupancy query says %d blocks per CU\n", per_cu); per_cu = 1; }
        (void)hipGetLastError();
        grid_blocks = cus;
    }
    if (grid_blocks < 0) return;
    Params p{};
    const float** pp = (const float**)&p;
    for (int i = 0; i < 16; ++i) pp[i] = (const float*)d_in[i];
    p.out = (float*)d_out; p.ws = (unsigned char*)d_ws;
    void* args[] = {&p};
    hipError_t e = hipLaunchCooperativeKernel((const void*)mk_fwd, dim3(grid_blocks), dim3(512), args, LDS_BYTES, stream);
    if (e != hipSuccess) fprintf(stderr, "cooperative launch failed: %s (grid %d)\n", hipGetErrorString(e), grid_blocks);
}
```

```cpp
#include <hip/hip_runtime.h>
#include <hip/hip_cooperative_groups.h>
#include <cstdio>
#include <cstdint>
#include <cmath>
namespace cg = cooperative_groups;
namespace pg8 {
#define PG8_LAS __attribute__((address_space(3)))
typedef unsigned short bf16_t;
typedef short bf16x8 __attribute__((ext_vector_type(8)));
typedef float f32x4 __attribute__((ext_vector_type(4)));
typedef unsigned u32x4 __attribute__((ext_vector_type(4)));
constexpr int BM = 256, BK = 64, HALF = 128, HTB = HALF * BK * 2  , STAGE_BYTES = 8 * HTB, NXCD = 8, WGM = 8;

__host__ __device__ __forceinline__ int lds_byte(int r, int c) { const int st = (r >> 4) * 2 + (c >> 5), rr = r & 15, cc = c & 31, ob = rr * 64 + cc * 2; return st * 1024 + (ob ^ (((ob >> 9) & 1) << 5)); }
__host__ __device__ __forceinline__ void stage_rc(int b, int& R, int& C) { const int st = b / 1024, sb = b % 1024, swz = sb ^ (((sb >> 9) & 1) << 5); R = (st >> 1) * 16 + swz / 64; C = (st & 1) * 32 + (swz % 64) / 2; }
__host__ __device__ __forceinline__ int perm32(int rho) { const int n = rho >> 4, i = rho & 15; return 8 * (i >> 2) + 4 * n + (i & 3); }

struct Unit { int pm, pn; };
struct Gemm { const bf16_t* A; const bf16_t* Bt; int M, N, K; };

struct StaticOrder {
    int nM, nN, nwg, G, c;
    __host__ __device__ void init(int M, int N, int G_, int c_) { nM = M / BM; nN = N / BM; nwg = nM * nN; G = G_; c = c_; }
    __host__ __device__ bool next(int i, Unit& u) const {
        const long L = (long)i * G + c; if (L >= nwg) return false;
        int wgid = (int)L; { const int q = nwg / NXCD, r = nwg % NXCD, xcd = wgid % NXCD, off = wgid / NXCD; wgid = (xcd < r ? xcd * (q + 1) : r * (q + 1) + (xcd - r) * q) + off; }
        const int nig = WGM * nN, gid = wgid / nig, fm = gid * WGM, gsz = (nM - fm) < WGM ? (nM - fm) : WGM;
        u.pm = fm + ((wgid % nig) % gsz); u.pn = (wgid % nig) / gsz; return true;
    }
    __device__ __forceinline__ void a_ready(const Unit&) const {}
    __device__ __forceinline__ void done(const Unit&) const {}
};

template <class Epi, class Sched, bool ALIGN_EPI = false, bool SP2 = false>
__device__ __forceinline__ void gemm_phase(PG8_LAS unsigned char* lds, const Gemm g, const Sched& S, const Epi& E) {
    int tid_ = threadIdx.x; asm volatile("" : "+v"(tid_));
    const int tid = tid_, wid = __builtin_amdgcn_readfirstlane(tid >> 6), lane = tid & 63, wr = wid >> 2, wc = wid & 3, fr = lane & 15, fq = lane >> 4;
    const int K = g.K, nt = K / BK;
    unsigned voffA[2], voffB[2];
#pragma unroll
    for (int i = 0; i < 2; ++i) { int R, C; stage_rc(tid * 16 + i * 8192, R, C); const int Rb = Epi::PERM ? ((R & ~31) + perm32(R & 31)) : R;
        voffA[i] = (unsigned)(R * K + C) * 2u; voffB[i] = (unsigned)(Rb * K + C) * 2u; }
    const size_t kstep = (size_t)(BK * 2);
    const size_t hstep = (size_t)HALF * K * 2;
    const size_t tstep = 2 * hstep;
    const unsigned ldsw = (unsigned)wid * 1024u;
    const int aoff = lds_byte(wr * 64 + fr, fq * 8), boff = lds_byte(wc * 32 + fr, fq * 8);
#define PG8_SA(b, h) (((b) * 2 + (h)) * HTB)
#define PG8_SB(b, h) ((4 + (b) * 2 + (h)) * HTB)
#define PG8_STAGE(bufoff, gbase, voff) do { _Pragma("unroll") for (int _i = 0; _i < 2; ++_i) \
        __builtin_amdgcn_global_load_lds((const unsigned*)((const char*)(gbase) + (voff)[_i]), (PG8_LAS unsigned*)(lds + (bufoff) + ldsw + _i * 8192), 16, 0, 0); } while (0)
#define PG8_LDA(dst, b, h) do { _Pragma("unroll") for (int m = 0; m < 4; ++m) _Pragma("unroll") for (int k = 0; k < 2; ++k) dst[m][k] = *(const PG8_LAS bf16x8*)(lds + PG8_SA(b, h) + aoff + m * 2048 + k * 1024); } while (0)
#define PG8_LDB(dst, b, h) do { _Pragma("unroll") for (int n = 0; n < 2; ++n) _Pragma("unroll") for (int k = 0; k < 2; ++k) dst[n][k] = *(const PG8_LAS bf16x8*)(lds + PG8_SB(b, h) + boff + n * 2048 + k * 1024); } while (0)
#define PG8_MMA(ai, bj, At, Bt) do { __builtin_amdgcn_s_setprio(1); _Pragma("unroll") for (int m = 0; m < 4; ++m) _Pragma("unroll") for (int n = 0; n < 2; ++n) _Pragma("unroll") for (int k = 0; k < 2; ++k) \
        acc[ai][bj][m][n] = __builtin_amdgcn_mfma_f32_16x16x32_bf16(Bt[n][k], At[m][k], acc[ai][bj][m][n], 0, 0, 0); __builtin_amdgcn_s_setprio(0); } while (0)
#define PG8_WAIT_V(n) asm volatile("s_waitcnt vmcnt(" #n ")" ::: "memory")
#define PG8_WAIT_L(n) asm volatile("s_waitcnt lgkmcnt(" #n ")" ::: "memory")
#define PG8_BAR __builtin_amdgcn_s_barrier()
#define PG8_SCHED __builtin_amdgcn_sched_barrier(0)
    Unit cur, nxt; int ui = 0;
    if (!S.next(0, cur)) return;
    f32x4 acc[2][2][4][2];
#pragma unroll
    for (int a = 0; a < 2; ++a)
#pragma unroll
        for (int b = 0; b < 2; ++b)
#pragma unroll
            for (int m = 0; m < 4; ++m)
#pragma unroll
                for (int n = 0; n < 2; ++n) acc[a][b][m][n] = (f32x4){0.f, 0.f, 0.f, 0.f};
    bf16x8 At[4][2], B0[2][2], B1[2][2];
    const char* cA = (const char*)g.A + (size_t)cur.pm * tstep; const char* cB = (const char*)g.Bt + (size_t)cur.pn * tstep;
    S.a_ready(cur);
    if constexpr (SP2) {
        PG8_STAGE(PG8_SB(0, 0), cB, voffB); PG8_STAGE(PG8_SB(0, 1), cB + hstep, voffB); PG8_STAGE(PG8_SA(0, 0), cA, voffA); PG8_STAGE(PG8_SA(0, 1), cA + hstep, voffA);
        if (wr == 1) PG8_BAR;
        PG8_WAIT_V(2); PG8_BAR;
        PG8_STAGE(PG8_SB(1, 0), cB + kstep, voffB); PG8_STAGE(PG8_SA(1, 0), cA + kstep, voffA); PG8_STAGE(PG8_SB(1, 1), cB + hstep + kstep, voffB);
        PG8_WAIT_V(6); PG8_BAR;
    } else {
        PG8_STAGE(PG8_SB(0, 0), cB, voffB); PG8_STAGE(PG8_SA(0, 0), cA, voffA); PG8_STAGE(PG8_SB(0, 1), cB + hstep, voffB); PG8_STAGE(PG8_SA(0, 1), cA + hstep, voffA);
        if (wr == 1) PG8_BAR;
        PG8_WAIT_V(4); PG8_BAR;
        PG8_STAGE(PG8_SB(1, 0), cB + kstep, voffB); PG8_STAGE(PG8_SA(1, 0), cA + kstep, voffA); PG8_STAGE(PG8_SB(1, 1), cB + hstep + kstep, voffB);
        PG8_WAIT_V(6); PG8_BAR;
    }
    for (;;) {
        const bool has_next = S.next(ui + 1, nxt);
        const char* nA = has_next ? (const char*)g.A + (size_t)nxt.pm * tstep : cA; const char* nB = has_next ? (const char*)g.Bt + (size_t)nxt.pn * tstep : cB;
        for (int t = 0; t < nt; t += 2) {
            const bool last = (t == nt - 2);
            const char* a1 = cA + (size_t)(t + 1) * kstep;
            const char* a2 = last ? nA : cA + (size_t)(t + 2) * kstep; const char* b2 = last ? nB : cB + (size_t)(t + 2) * kstep;
            const char* a3 = a2 + kstep; const char* b3 = b2 + kstep;
            if (last && has_next) S.a_ready(nxt);
            if constexpr (SP2) {
            PG8_LDB(B0, 0, 0); PG8_LDB(B1, 0, 1); PG8_SCHED; PG8_LDA(At, 0, 0); PG8_STAGE(PG8_SA(1, 1), a1 + hstep, voffA);
            PG8_WAIT_V(8); PG8_WAIT_L(0); PG8_BAR; PG8_MMA(0, 0, At, B0); PG8_MMA(0, 1, At, B1); PG8_BAR; PG8_SCHED;
            PG8_LDA(At, 0, 1); PG8_STAGE(PG8_SB(0, 0), b2, voffB); PG8_STAGE(PG8_SB(0, 1), b2 + hstep, voffB); PG8_STAGE(PG8_SA(0, 0), a2, voffA);
            PG8_WAIT_V(8); PG8_WAIT_L(0); PG8_BAR; PG8_MMA(1, 0, At, B0); PG8_MMA(1, 1, At, B1); PG8_BAR; PG8_SCHED;
            PG8_LDB(B0, 1, 0); PG8_LDB(B1, 1, 1); PG8_SCHED; PG8_LDA(At, 1, 0); PG8_STAGE(PG8_SA(0, 1), a2 + hstep, voffA);
            PG8_WAIT_V(8); PG8_WAIT_L(0); PG8_BAR; PG8_MMA(0, 0, At, B0); PG8_MMA(0, 1, At, B1); PG8_BAR; PG8_SCHED;
            PG8_LDA(At, 1, 1); PG8_STAGE(PG8_SB(1, 0), b3, voffB); PG8_STAGE(PG8_SB(1, 1), b3 + hstep, voffB); PG8_STAGE(PG8_SA(1, 0), a3, voffA);
            PG8_WAIT_V(8); PG8_WAIT_L(0); PG8_BAR; PG8_MMA(1, 0, At, B0); PG8_MMA(1, 1, At, B1); PG8_BAR; PG8_SCHED;
            } else {
            PG8_LDB(B0, 0, 0); PG8_SCHED; PG8_LDA(At, 0, 0); PG8_STAGE(PG8_SA(1, 1), a1 + hstep, voffA);
            PG8_WAIT_L(8); PG8_BAR; PG8_WAIT_L(0); PG8_MMA(0, 0, At, B0); PG8_BAR; PG8_SCHED;
            PG8_LDB(B1, 0, 1); PG8_STAGE(PG8_SB(0, 0), b2, voffB);
            PG8_BAR; PG8_WAIT_L(0); PG8_MMA(0, 1, At, B1); PG8_BAR;
            PG8_LDA(At, 0, 1); PG8_STAGE(PG8_SA(0, 0), a2, voffA);
            PG8_BAR; PG8_WAIT_L(0); PG8_MMA(1, 0, At, B0); PG8_BAR; PG8_SCHED;
            PG8_STAGE(PG8_SB(0, 1), b2 + hstep, voffB);
            PG8_WAIT_V(6); PG8_BAR; PG8_MMA(1, 1, At, B1); PG8_BAR;
            PG8_LDB(B0, 1, 0); PG8_SCHED; PG8_LDA(At, 1, 0); PG8_STAGE(PG8_SA(0, 1), a2 + hstep, voffA);
            PG8_WAIT_L(8); PG8_BAR; PG8_WAIT_L(0); PG8_MMA(0, 0, At, B0); PG8_BAR; PG8_SCHED;
            PG8_LDB(B1, 1, 1); PG8_STAGE(PG8_SB(1, 0), b3, voffB);
            PG8_BAR; PG8_WAIT_L(0); PG8_MMA(0, 1, At, B1); PG8_BAR;
            PG8_LDA(At, 1, 1); PG8_STAGE(PG8_SA(1, 0), a3, voffA);
            PG8_BAR; PG8_WAIT_L(0); PG8_MMA(1, 0, At, B0); PG8_BAR; PG8_SCHED;
            PG8_STAGE(PG8_SB(1, 1), b3 + hstep, voffB);
            PG8_WAIT_V(6); PG8_BAR; PG8_MMA(1, 1, At, B1); PG8_BAR;
            }
            if constexpr (Epi::MID_HOOK) { if (t == Epi::MID_T) E.mid(acc, cur, wr, wc, fr, fq); }
        }
        if constexpr (ALIGN_EPI) { if (wr == 0) PG8_BAR; }
        if constexpr (!Epi::AFTER_DRAIN) { E(acc, cur, wr, wc, fr, fq); S.done(cur); }
        if (!has_next) break;
#pragma unroll
        for (int a = 0; a < 2; ++a)
#pragma unroll
            for (int b = 0; b < 2; ++b)
#pragma unroll
                for (int m = 0; m < 4; ++m)
#pragma unroll
                    for (int n = 0; n < 2; ++n) acc[a][b][m][n] = (f32x4){0.f, 0.f, 0.f, 0.f};
        cur = nxt; cA = nA; cB = nB; ++ui;
        if constexpr (ALIGN_EPI) { if (wr == 1) PG8_BAR; }
    }
    PG8_WAIT_V(0);
    if constexpr (!ALIGN_EPI) { if (wr == 0) PG8_BAR; }
    PG8_BAR;
    if constexpr (Epi::AFTER_DRAIN) { E.fused(acc, cur, wr, wc, fr, fq, lds, wid, lane); S.done(cur); }
#undef PG8_SA
#undef PG8_SB
#undef PG8_STAGE
#undef PG8_LDA
#undef PG8_LDB
#undef PG8_MMA
#undef PG8_WAIT_V
#undef PG8_WAIT_L
#undef PG8_BAR
#undef PG8_SCHED
}
}
#define LAS __attribute__((address_space(3)))
typedef unsigned short bf16_t;
typedef short bf16x8 __attribute__((ext_vector_type(8)));
typedef float f32x4 __attribute__((ext_vector_type(4)));
typedef float f32x2 __attribute__((ext_vector_type(2)));
typedef float f32x16 __attribute__((ext_vector_type(16)));
typedef unsigned u32x4 __attribute__((ext_vector_type(4)));
typedef unsigned u32x2 __attribute__((ext_vector_type(2)));
typedef __bf16 bf16x2_t __attribute__((ext_vector_type(2)));

constexpr int S = 16384, D = 1024, DEPTH = 4, NIN = 3584  , FF = 4096;
constexpr float EPS = 1e-6f;
constexpr float QSCALE = 0.125f * 1.4426950408889634f;
constexpr float LOG2E = 1.4426950408889634f;

__device__ __forceinline__ unsigned pk2(float lo, float hi) { f32x2 v = {lo, hi}; bf16x2_t b = __builtin_convertvector(v, bf16x2_t); return __builtin_bit_cast(unsigned, b); }
__device__ __forceinline__ float bf2f(bf16_t v) { return __uint_as_float(((unsigned)v) << 16); }
__device__ __forceinline__ bf16_t f2bf(float f) { return (bf16_t)(pk2(f, 0.f) & 0xffffu); }
__device__ __forceinline__ float wave_sum(float v) {
#pragma unroll
    for (int o = 1; o < 64; o <<= 1) v += __shfl_xor(v, o);
    return v;
}
__device__ __forceinline__ float half_swap_sum(float v) { auto rr = __builtin_amdgcn_permlane32_swap(__float_as_uint(v), __float_as_uint(v), false, false); return __uint_as_float(rr[0]) + __uint_as_float(rr[1]); }
__device__ __forceinline__ float half_swap_max(float v) { auto rr = __builtin_amdgcn_permlane32_swap(__float_as_uint(v), __float_as_uint(v), false, false); return fmaxf(__uint_as_float(rr[0]), __uint_as_float(rr[1])); }

__device__ __forceinline__ float row_rstd(const float* ssq, int row) {
    const f32x4* p = (const f32x4*)(ssq + (size_t)row * 16);
    const f32x4 a = p[0], b = p[1], c = p[2], d = p[3];
    const f32x4 s = (a + b) + (c + d);
    const float t = (s[0] + s[1]) + (s[2] + s[3]);
    return __builtin_amdgcn_rsqf(t * (1.f / 1024.f) + EPS);
}

using pg8::Unit;
typedef f32x4 acc_t[2][2][4][2];

struct EpiInProj {
    static constexpr bool PERM = true, AFTER_DRAIN = false, MID_HOOK = false; static constexpr int MID_T = -1;
    const float* ssq; bf16_t* Q; bf16_t* Kb; bf16_t* xp; bf16_t* gates; const float* qg; const float* kg; const float* bg;
    __device__ __forceinline__ void operator()(const acc_t& acc, const Unit& u, int wr, int wc, int fr, int fq) const {
        const int row0 = u.pm * 256 + wr * 64 + fr, pn = u.pn;
        if (pn < 4) {
            const bool isq = pn < 2; const float* g = isq ? qg : kg; const float sc = isq ? QSCALE : 1.f;
            bf16_t* base = (isq ? Q : Kb) + (size_t)((pn & 1) * 4 + wc) * S * 64;
            f32x4 gv[2][2];
#pragma unroll
            for (int bj = 0; bj < 2; ++bj)
#pragma unroll
                for (int n = 0; n < 2; ++n) gv[bj][n] = *(const f32x4*)(g + 32 * bj + 8 * fq + 4 * n) * sc;
#pragma unroll
            for (int ai = 0; ai < 2; ++ai)
#pragma unroll
                for (int m = 0; m < 4; ++m) {
                    const int row = row0 + ai * 128 + m * 16; const float rs = row_rstd(ssq, row);
                    f32x4 v[2][2]; float ss = 0.f;
#pragma unroll
                    for (int bj = 0; bj < 2; ++bj)
#pragma unroll
                        for (int n = 0; n < 2; ++n) { v[bj][n] = acc[ai][bj][m][n] * rs; const f32x4 q2 = v[bj][n] * v[bj][n]; ss += (q2[0] + q2[1]) + (q2[2] + q2[3]); }
                    ss += __shfl_xor(ss, 16); ss += __shfl_xor(ss, 32);
                    const float r2 = __builtin_amdgcn_rsqf(ss * (1.f / 64.f) + EPS);
#pragma unroll
                    for (int bj = 0; bj < 2; ++bj) { const f32x4 a = v[bj][0] * r2 * gv[bj][0], b = v[bj][1] * r2 * gv[bj][1];
                        u32x4 w; w.x = pk2(a[0], a[1]); w.y = pk2(a[2], a[3]); w.z = pk2(b[0], b[1]); w.w = pk2(b[2], b[3]);
                        *(u32x4*)(base + (size_t)row * 64 + 32 * bj + 8 * fq) = w; }
                }
        } else if (pn < 6) {
            const int col0 = (pn - 4) * 256 + wc * 32 + 8 * fq;
#pragma unroll
            for (int ai = 0; ai < 2; ++ai)
#pragma unroll
                for (int m = 0; m < 4; ++m) {
                    const int row = row0 + ai * 128 + m * 16; const float rs = row_rstd(ssq, row);
#pragma unroll
                    for (int bj = 0; bj < 2; ++bj) { const f32x4 a = acc[ai][bj][m][0] * rs, b = acc[ai][bj][m][1] * rs;
                        u32x4 w; w.x = pk2(a[0], a[1]); w.y = pk2(a[2], a[3]); w.z = pk2(b[0], b[1]); w.w = pk2(b[2], b[3]);
                        *(u32x4*)(xp + (size_t)row * 512 + col0 + bj * 128) = w; }
                }
        } else {
            const int col0 = (pn - 6) * 256 + wc * 32 + 8 * fq;
            f32x4 bv[2][2];
#pragma unroll
            for (int bj = 0; bj < 2; ++bj)
#pragma unroll
                for (int n = 0; n < 2; ++n) bv[bj][n] = *(const f32x4*)(bg + col0 + bj * 128 + 4 * n) * (-LOG2E);
#pragma unroll
            for (int ai = 0; ai < 2; ++ai)
#pragma unroll
                for (int m = 0; m < 4; ++m) {
                    const int row = row0 + ai * 128 + m * 16; const float rs = row_rstd(ssq, row) * (-LOG2E);
#pragma unroll
                    for (int bj = 0; bj < 2; ++bj) { f32x4 a = acc[ai][bj][m][0] * rs + bv[bj][0], b = acc[ai][bj][m][1] * rs + bv[bj][1];
#pragma unroll
                        for (int j = 0; j < 4; ++j) { a[j] = __builtin_amdgcn_rcpf(1.f + __builtin_amdgcn_exp2f(a[j])); b[j] = __builtin_amdgcn_rcpf(1.f + __builtin_amdgcn_exp2f(b[j])); }
                        u32x4 w; w.x = pk2(a[0], a[1]); w.y = pk2(a[2], a[3]); w.z = pk2(b[0], b[1]); w.w = pk2(b[2], b[3]);
                        *(u32x4*)(gates + (size_t)row * 2048 + col0 + bj * 128) = w; }
                }
        }
    }
};

struct EpiVT {
    static constexpr bool PERM = false, AFTER_DRAIN = false, MID_HOOK = false; static constexpr int MID_T = -1;
    const float* ssq; bf16_t* VT;
    __device__ __forceinline__ void operator()(const acc_t& acc, const Unit& u, int wr, int wc, int fr, int fq) const {
        const int f0 = u.pm * 256 + wr * 64 + fr; const int sfq = ((fq & 1) << 1) | (fq >> 1);
#pragma unroll
        for (int bj = 0; bj < 2; ++bj)
#pragma unroll
            for (int n = 0; n < 2; ++n) {
                const int tg = u.pn * 256 + bj * 128 + wc * 32 + n * 16; const int tok = tg + 4 * fq;
                f32x4 rs; rs[0] = row_rstd(ssq, tok); rs[1] = row_rstd(ssq, tok + 1); rs[2] = row_rstd(ssq, tok + 2); rs[3] = row_rstd(ssq, tok + 3);
#pragma unroll
                for (int ai = 0; ai < 2; ++ai)
#pragma unroll
                    for (int m = 0; m < 4; ++m) { const f32x4 v = acc[ai][bj][m][n] * rs; u32x2 w; w.x = pk2(v[0], v[1]); w.y = pk2(v[2], v[3]);
                        const int f = f0 + ai * 128 + m * 16;
                        *(u32x2*)(VT + ((size_t)((f >> 7) * 256 + (tg >> 6)) * 128 + (f & 127)) * 64 + (tg & 63) + 4 * sfq) = w; }
            }
    }
};

struct EpiUp {
    static constexpr bool PERM = true, AFTER_DRAIN = false, MID_HOOK = true; static constexpr int MID_T = 6;
    const bf16_t* gates; bf16_t* merged;
    static __device__ __forceinline__ void unpack8(const u32x4 w, f32x4& a, f32x4& b) {
        a[0] = __uint_as_float(w.x << 16); a[1] = __uint_as_float(w.x & 0xffff0000u); a[2] = __uint_as_float(w.y << 16); a[3] = __uint_as_float(w.y & 0xffff0000u);
        b[0] = __uint_as_float(w.z << 16); b[1] = __uint_as_float(w.z & 0xffff0000u); b[2] = __uint_as_float(w.w << 16); b[3] = __uint_as_float(w.w & 0xffff0000u);
    }
    __device__ __forceinline__ void mid(acc_t& acc, const Unit& u, int, int, int, int) const {
        int tid = threadIdx.x; asm volatile("" : "+v"(tid));
        const int wid = tid >> 6, lane = tid & 63, wr = wid >> 2, wc = wid & 3, fr = lane & 15, fq = lane >> 4;
        const int row0 = u.pm * 256 + wr * 64 + fr, col0 = u.pn * 256 + wc * 32 + 8 * fq;
#pragma unroll
        for (int ai = 0; ai < 2; ++ai)
#pragma unroll
            for (int m = 0; m < 4; ++m) { const bf16_t* gr = gates + (size_t)(row0 + ai * 128 + m * 16) * 2048 + col0;
#pragma unroll
                for (int bj = 0; bj < 2; ++bj) { f32x4 a0, a1, b0, b1; unpack8(*(const u32x4*)(gr + bj * 128), a0, a1); unpack8(*(const u32x4*)(gr + 1024 + bj * 128), b0, b1);
#pragma unroll
                    for (int j = 0; j < 4; ++j) { a0[j] *= __builtin_amdgcn_rcpf(fmaxf(b0[j], 1e-20f)); a1[j] *= __builtin_amdgcn_rcpf(fmaxf(b1[j], 1e-20f)); }
                    acc[ai][bj][m][0] *= a0; acc[ai][bj][m][1] *= a1; }
                asm volatile("" ::: "memory"); }
    }
    __device__ __forceinline__ void operator()(const acc_t& acc, const Unit& u, int wr, int wc, int fr, int fq) const {
        const int row0 = u.pm * 256 + wr * 64 + fr, col0 = u.pn * 256 + wc * 32 + 8 * fq;
#pragma unroll
        for (int ai = 0; ai < 2; ++ai)
#pragma unroll
            for (int m = 0; m < 4; ++m) { const int row = row0 + ai * 128 + m * 16; const bf16_t* gr = gates + (size_t)row * 2048 + 1024 + col0;
#pragma unroll
                for (int bj = 0; bj < 2; ++bj) { f32x4 b0, b1; unpack8(*(const u32x4*)(gr + bj * 128), b0, b1);
#pragma unroll
                    for (int j = 0; j < 4; ++j) { b0[j] = fmaxf(b0[j], 1e-20f); b1[j] = fmaxf(b1[j], 1e-20f); }
                    const f32x4 a = acc[ai][bj][m][0] * b0, b = acc[ai][bj][m][1] * b1;
                    u32x4 w; w.x = pk2(a[0], a[1]); w.y = pk2(a[2], a[3]); w.z = pk2(b[0], b[1]); w.w = pk2(b[2], b[3]);
                    *(u32x4*)(merged + (size_t)row * 1024 + col0 + bj * 128) = w; } }
    }
};
template <bool IN_F32, bool OUT_F32>
struct EpiResid {
    static constexpr bool PERM = false, AFTER_DRAIN = false, MID_HOOK = false; static constexpr int MID_T = -1;
    const float* xin; float* xout; bf16_t* xb; float* ssq;
    __device__ __forceinline__ void operator()(const acc_t& acc, const Unit& u, int wr, int wc, int fr, int fq) const {
        const int row0 = u.pm * 256 + wr * 64 + fr, col0 = u.pn * 256 + wc * 32 + 4 * fq;
#pragma unroll
        for (int ai = 0; ai < 2; ++ai) {
            f32x4 xv[4][2][2];
#pragma unroll
            for (int m = 0; m < 4; ++m)
#pragma unroll
                for (int bj = 0; bj < 2; ++bj)
#pragma unroll
                    for (int n = 0; n < 2; ++n) { const size_t off = (size_t)(row0 + ai * 128 + m * 16) * 1024 + col0 + bj * 128 + n * 16;
                        if (IN_F32) xv[m][bj][n] = *(const f32x4*)(xin + off);
                        else { const u32x2 h = *(const u32x2*)(xb + off);
                            xv[m][bj][n][0] = __uint_as_float(h.x << 16); xv[m][bj][n][1] = __uint_as_float(h.x & 0xffff0000u); xv[m][bj][n][2] = __uint_as_float(h.y << 16); xv[m][bj][n][3] = __uint_as_float(h.y & 0xffff0000u); } }
#pragma unroll
            for (int m = 0; m < 4; ++m) { const int row = row0 + ai * 128 + m * 16; float ss = 0.f;
#pragma unroll
                for (int bj = 0; bj < 2; ++bj)
#pragma unroll
                    for (int n = 0; n < 2; ++n) { const size_t off = (size_t)row * 1024 + col0 + bj * 128 + n * 16;
                        const f32x4 v = xv[m][bj][n] + acc[ai][bj][m][n];
                        if (OUT_F32) *(f32x4*)(xout + off) = v;
                        else { u32x2 w; w.x = pk2(v[0], v[1]); w.y = pk2(v[2], v[3]); *(u32x2*)(xb + off) = w;
                            const f32x4 q2 = v * v; ss += (q2[0] + q2[1]) + (q2[2] + q2[3]); } }
                if (!OUT_F32) { ss += __shfl_xor(ss, 16); ss += __shfl_xor(ss, 32);
                    if (fq == 0) ssq[(size_t)row * 16 + u.pn * 4 + wc] = ss; } }
        }
    }
};
struct EpiMlpIn {
    static constexpr bool PERM = true, AFTER_DRAIN = false, MID_HOOK = false; static constexpr int MID_T = -1;
    const float* ssq; bf16_t* U;
    __device__ __forceinline__ void operator()(const acc_t& acc, const Unit& u, int wr, int wc, int fr, int fq) const {
        const int row0 = u.pm * 256 + wr * 64 + fr, col0 = u.pn * 256 + wc * 32 + 8 * fq;
#pragma unroll
        for (int ai = 0; ai < 2; ++ai)
#pragma unroll
            for (int m = 0; m < 4; ++m) { const int row = row0 + ai * 128 + m * 16; const float rs = row_rstd(ssq, row);
#pragma unroll
                for (int bj = 0; bj < 2; ++bj) { f32x4 a = acc[ai][bj][m][0] * rs, b = acc[ai][bj][m][1] * rs;
#pragma unroll
                    for (int j = 0; j < 4; ++j) { a[j] = fmaxf(a[j], 0.f); a[j] *= a[j]; b[j] = fmaxf(b[j], 0.f); b[j] *= b[j]; }
                    u32x4 w; w.x = pk2(a[0], a[1]); w.y = pk2(a[2], a[3]); w.z = pk2(b[0], b[1]); w.w = pk2(b[2], b[3]);
                    *(u32x4*)(U + (size_t)row * FF + col0 + bj * 128) = w; } }
    }
};
constexpr size_t MiB = 1u << 20;
constexpr size_t WS_SSQ = 0;
constexpr size_t WS_WIN = 1 * MiB, WS_WV = 8 * MiB, WS_WUA = 9 * MiB, WS_WPP = 10 * MiB, WS_WO = 11 * MiB, WS_W1 = 13 * MiB, WS_W2 = 21 * MiB;
constexpr size_t WS_BAR = 29 * MiB;
constexpr size_t WS_XB = 32 * MiB;
constexpr size_t WS_Q = 64 * MiB, WS_K = 80 * MiB, WS_VT = 96 * MiB, WS_XP = 112 * MiB, WS_GATES = 128 * MiB;
constexpr size_t WS_U = 64 * MiB;
constexpr size_t WS_A = 192 * MiB  , WS_MERGED = 224 * MiB, WS_END = 256 * MiB;
constexpr int LDS_BYTES = 131072 + 1024;

__device__ __forceinline__ void transpose_item(const float* W, int ldw, int Kd, const float* gk, bf16_t* WTrow0, int k0, int n0, LAS float* scr, int lane) {
    float tv[32];
#pragma unroll
    for (int i = 0; i < 32; ++i) tv[i] = W[(size_t)(k0 + 2 * i + (lane >> 5)) * ldw + n0 + (lane & 31)];
    if (gk) {
        float gvv[32];
#pragma unroll
        for (int i = 0; i < 32; ++i) gvv[i] = gk[k0 + 2 * i + (lane >> 5)];
#pragma unroll
        for (int i = 0; i < 32; ++i) tv[i] *= gvv[i];
    }
#pragma unroll
    for (int i = 0; i < 32; ++i) scr[(2 * i + (lane >> 5)) * 33 + (lane & 31)] = tv[i];
    asm volatile("s_waitcnt lgkmcnt(0)" ::: "memory");
    const int c = lane & 7;
#pragma unroll
    for (int j = 0; j < 4; ++j) { const int n = (lane >> 3) + 8 * j; const LAS float* s = scr + (8 * c) * 33 + n;
        u32x4 o; o.x = pk2(s[0 * 33], s[1 * 33]); o.y = pk2(s[2 * 33], s[3 * 33]); o.z = pk2(s[4 * 33], s[5 * 33]); o.w = pk2(s[6 * 33], s[7 * 33]);
        *(u32x4*)(WTrow0 + (size_t)n * Kd + k0 + 8 * c) = o; }
    asm volatile("s_waitcnt lgkmcnt(0)" ::: "memory");
}

struct Params {
    const float *x, *norm1_g, *w_in, *b_gate, *q_norm_g, *k_norm_g, *lam_params, *subln_g, *pool_w, *pool_scale, *w_up_attn, *w_up_pool, *w_o, *norm2_g, *w_mlp_in, *w_mlp_out;
    float* out; unsigned char* ws;
};

__device__ __forceinline__ void prep_phase(const Params& p, int l, LAS unsigned char* lds) {
    int tid_ = threadIdx.x; asm volatile("" : "+v"(tid_));
    const int lane = tid_ & 63, wave = __builtin_amdgcn_readfirstlane(tid_ >> 6);
    LAS float* scr = (LAS float*)(lds + wave * 16384);
    const int gw = blockIdx.x * 8 + wave, NGW = gridDim.x * 8;
    unsigned char* ws = p.ws;
    bf16_t* WinT = (bf16_t*)(ws + WS_WIN); bf16_t* WvT = (bf16_t*)(ws + WS_WV); bf16_t* WuaT = (bf16_t*)(ws + WS_WUA);
    bf16_t* WoT = (bf16_t*)(ws + WS_WO); bf16_t* W1T = (bf16_t*)(ws + WS_W1); bf16_t* W2T = (bf16_t*)(ws + WS_W2);
    const float* w_in = p.w_in + (size_t)l * D * 4096; const float* g1 = p.norm1_g + l * D; const float* g2 = p.norm2_g + l * D;
    const float* wua = p.w_up_attn + (size_t)l * 512 * D; const float* wup = p.w_up_pool + (size_t)l * 512 * D; const float* wo = p.w_o + (size_t)l * D * D;
    const float* w1 = p.w_mlp_in + (size_t)l * D * FF; const float* w2 = p.w_mlp_out + (size_t)l * FF * D;
    const float* pw = p.pool_w + (size_t)l * 4 * 128 * 128; const float* ps = p.pool_scale + l * 512;
    constexpr int I_PP = 2048, I_IN = 16 * 128, I_UA = 8 * 32, I_O = 16 * 32, I_1 = 16 * 128, I_2 = 64 * 32;
    constexpr int NITEMS = I_PP + I_IN + I_UA + I_O + I_1 + I_2;
    for (int it = gw; it < NITEMS; it += NGW) {
        int r = it;
        if (r < I_PP) {
            const int g = r >> 9, d0 = ((r >> 1) & 255) * 4, cblk = r & 1; const int c = cblk * 64 + lane;
            const float* pwr = pw + (size_t)(g * 128 + c) * 128; const float* psg = ps + g * 128; const float* wu = wup + (size_t)(g * 128) * D + d0;
            f32x4 pwv[32];
#pragma unroll
            for (int jj = 0; jj < 32; ++jj) pwv[jj] = *(const f32x4*)(pwr + 4 * jj);
#pragma unroll
            for (int i = 0; i < 8; ++i) { const int idx = i * 64 + lane; scr[idx] = wu[(size_t)(idx >> 2) * D + (idx & 3)]; }
            asm volatile("s_waitcnt lgkmcnt(0)" ::: "memory");
            f32x4 acc = {0.f, 0.f, 0.f, 0.f};
#pragma unroll
            for (int jj = 0; jj < 32; ++jj) { const f32x4 a4 = pwv[jj] * *(const f32x4*)(psg + 4 * jj);
#pragma unroll
                for (int t = 0; t < 4; ++t) acc += *(const LAS f32x4*)(scr + (4 * jj + t) * 4) * a4[t]; }
#pragma unroll
            for (int dd = 0; dd < 4; ++dd) WuaT[(size_t)(d0 + dd) * 1024 + 512 + g * 128 + c] = f2bf(acc[dd]);
            asm volatile("s_waitcnt lgkmcnt(0)" ::: "memory");
            continue;
        }
        r -= I_PP;
        if (r < I_IN) { const int kb = r >> 7, nb = r & 127, n0 = nb * 32; bf16_t* dst;
            if (n0 < 1024) dst = WinT + (size_t)((n0 & ~255) + 128 * ((n0 >> 5) & 1) + 32 * ((n0 >> 6) & 3)) * D;
            else if (n0 < 1536) dst = WvT + (size_t)(n0 - 1024) * D;
            else dst = WinT + (size_t)(n0 - 512) * D;
            transpose_item(w_in, 4096, D, g1, dst, kb * 64, n0, scr, lane); continue; }
        r -= I_IN;
        if (r < I_UA) { const int kb = r >> 5, nb = r & 31; transpose_item(wua, D, 1024, nullptr, WuaT + (size_t)(nb * 32) * 1024, kb * 64, nb * 32, scr, lane); continue; }
        r -= I_UA;
        if (r < I_O) { const int kb = r >> 5, nb = r & 31; transpose_item(wo, D, D, nullptr, WoT + (size_t)(nb * 32) * D, kb * 64, nb * 32, scr, lane); continue; }
        r -= I_O;
        if (r < I_1) { const int kb = r >> 7, nb = r & 127; transpose_item(w1, FF, D, g2, W1T + (size_t)(nb * 32) * D, kb * 64, nb * 32, scr, lane); continue; }
        r -= I_1;
        { const int kb = r >> 5, nb = r & 31; transpose_item(w2, D, FF, nullptr, W2T + (size_t)(nb * 32) * FF, kb * 64, nb * 32, scr, lane); }
    }
    if (l == 0) {
        bf16_t* xb = (bf16_t*)(ws + WS_XB); float* ssq = (float*)(ws + WS_SSQ);
        for (int m = gw; m < S; m += NGW) {
            const f32x4* xr = (const f32x4*)(p.x + (size_t)m * D) + lane; u32x2* o8 = (u32x2*)(xb + (size_t)m * D) + lane; float s = 0.f;
#pragma unroll
            for (int j = 0; j < 4; ++j) { const f32x4 v = xr[64 * j]; s += (v[0] * v[0] + v[1] * v[1]) + (v[2] * v[2] + v[3] * v[3]); u32x2 w; w.x = pk2(v[0], v[1]); w.y = pk2(v[2], v[3]); o8[64 * j] = w; }
            s = wave_sum(s);
            if (lane < 16) ssq[(size_t)m * 16 + lane] = lane == 0 ? s : 0.f;
        }
    }
}

template <int W> __device__ __forceinline__ void pool_tile(const bf16_t* xp, bf16_t* pooled, int t0, int ch0) {
    u32x4 prev[W], cur[8];
#pragma unroll
    for (int k = 0; k < W; ++k) { const int t = t0 - W + k; prev[k] = t >= 0 ? *(const u32x4*)(xp + (size_t)t * 512 + ch0) : (u32x4){0u, 0u, 0u, 0u}; }
#pragma unroll
    for (int i = 0; i < 8; ++i) cur[i] = *(const u32x4*)(xp + (size_t)(t0 + i) * 512 + ch0);
    float s[8];
#pragma unroll
    for (int c = 0; c < 8; ++c) s[c] = 0.f;
#pragma unroll
    for (int k = 0; k < W; ++k)
#pragma unroll
        for (int c = 0; c < 4; ++c) { s[2 * c] += __uint_as_float(prev[k][c] << 16); s[2 * c + 1] += __uint_as_float(prev[k][c] & 0xffff0000u); }
#pragma unroll
    for (int i = 0; i < 8; ++i) {
        const u32x4 old = i < W ? prev[i < W ? i : 0] : cur[i >= W ? i - W : 0];
        const int t = t0 + i; const float cnt = (float)(t + 1 < W ? t + 1 : W);
        u32x4 o;
#pragma unroll
        for (int c = 0; c < 4; ++c) {
            const float c0 = __uint_as_float(cur[i][c] << 16), c1 = __uint_as_float(cur[i][c] & 0xffff0000u);
            s[2 * c] += c0 - __uint_as_float(old[c] << 16); s[2 * c + 1] += c1 - __uint_as_float(old[c] & 0xffff0000u);
            o[c] = pk2(s[2 * c] / cnt - c0, s[2 * c + 1] / cnt - c1);
        }
        *(u32x4*)(pooled + (size_t)t * 1024 + 512 + ch0) = o;
    }
}
__device__ __forceinline__ void pool_phase(const bf16_t* xp, bf16_t* pooled) {
    int tid_ = threadIdx.x; asm volatile("" : "+v"(tid_));
    const int lane = tid_ & 63, wave = __builtin_amdgcn_readfirstlane(tid_ >> 6);
    const int g = wave & 3, ch0 = g * 128 + (lane & 15) * 8, tsub = (wave >> 2) * 32 + (lane >> 4) * 8;
    for (int chunk = blockIdx.x; chunk < S / 64; chunk += gridDim.x) {
        const int t0 = chunk * 64 + tsub;
        if (g == 0) pool_tile<2>(xp, pooled, t0, ch0); else if (g == 1) pool_tile<4>(xp, pooled, t0, ch0); else if (g == 2) pool_tile<8>(xp, pooled, t0, ch0); else pool_tile<16>(xp, pooled, t0, ch0);
    }
}

constexpr int AT_ROWB = 144, AT_K2 = 64 * AT_ROWB, AT_KST = 2 * AT_K2  , AT_VST = 128 * AT_ROWB  , AT_VOFF = 2 * AT_KST;
#define MFMA32(a, b, c) __builtin_amdgcn_mfma_f32_32x32x16_bf16((a), (b), (c), 0, 0, 0)

__device__ __forceinline__ float at_max3(float a, float b, float c) { float r; asm("v_max3_f32 %0, %1, %2, %3" : "=v"(r) : "v"(a), "v"(b), "v"(c)); return r; }
__device__ __forceinline__ void at_qk_half(const bool ONLINE, const LAS unsigned char* kp, const bf16x8 (&qf)[4], int q, int q0, int kbase, int hh, float& mrun, f32x16 (&O)[4], f32x16& L, bf16x8 (&pf)[4]) {
    __builtin_amdgcn_s_setprio(3);
    bf16x8 kf[8];
#pragma unroll
    for (int s = 0; s < 4; ++s) { kf[2 * s] = *(const LAS bf16x8*)(kp + 32 * s); kf[2 * s + 1] = *(const LAS bf16x8*)(kp + 32 * AT_ROWB + 32 * s); }
    __builtin_amdgcn_sched_barrier(0);
    f32x16 s0, s1;
#pragma unroll
    for (int i = 0; i < 16; ++i) { s0[i] = 0.f; s1[i] = 0.f; }
#pragma unroll
    for (int s = 0; s < 4; ++s) { s0 = MFMA32(kf[2 * s], qf[s], s0); s1 = MFMA32(kf[2 * s + 1], qf[s], s1); }
    if (kbase + 63 > q0) {
        const int kb = kbase + 4 * hh;
#pragma unroll
        for (int i = 0; i < 16; ++i) { const int kv = kb + (i & 3) + 8 * (i >> 2); if (kv > q) s0[i] = -INFINITY; if (kv + 32 > q) s1[i] = -INFINITY; }
    }
    if (ONLINE) {
#pragma unroll
        for (int i = 0; i < 16; ++i) { s0[i] -= mrun; s1[i] -= mrun; }
        float mx = fmaxf(s0[0], s1[0]);
#pragma unroll
        for (int i = 1; i < 16; ++i) mx = at_max3(mx, s0[i], s1[i]);
        mx = half_swap_max(mx);
        if (__builtin_amdgcn_ballot_w64(mx > 8.f) != 0ull) {
            const float d = fmaxf(mx, 0.f); const float alpha = __builtin_amdgcn_exp2f(-d); mrun += d;
#pragma unroll
            for (int e = 0; e < 4; ++e)
#pragma unroll
                for (int i = 0; i < 16; ++i) O[e][i] *= alpha;
#pragma unroll
            for (int i = 0; i < 16; ++i) { L[i] *= alpha; s0[i] -= d; s1[i] -= d; }
        }
    }
#pragma unroll
    for (int i = 0; i < 16; ++i) { s0[i] = __builtin_amdgcn_exp2f(s0[i]); s1[i] = __builtin_amdgcn_exp2f(s1[i]); }
#pragma unroll
    for (int s2 = 0; s2 < 2; ++s2) {
        u32x4 a, b;
        a.x = pk2(s0[8 * s2 + 0], s0[8 * s2 + 1]); a.y = pk2(s0[8 * s2 + 2], s0[8 * s2 + 3]); a.z = pk2(s0[8 * s2 + 4], s0[8 * s2 + 5]); a.w = pk2(s0[8 * s2 + 6], s0[8 * s2 + 7]);
        b.x = pk2(s1[8 * s2 + 0], s1[8 * s2 + 1]); b.y = pk2(s1[8 * s2 + 2], s1[8 * s2 + 3]); b.z = pk2(s1[8 * s2 + 4], s1[8 * s2 + 5]); b.w = pk2(s1[8 * s2 + 6], s1[8 * s2 + 7]);
        pf[s2] = __builtin_bit_cast(bf16x8, a); pf[2 + s2] = __builtin_bit_cast(bf16x8, b);
    }
    __builtin_amdgcn_s_setprio(0);
}
__device__ __forceinline__ void at_pv_half(const LAS unsigned char* vp, const bf16x8 (&pf)[4], f32x16 (&O)[4], f32x16& L) {
    bf16x8 va[8], vb[8];
#pragma unroll
    for (int e = 0; e < 2; ++e)
#pragma unroll
        for (int ks = 0; ks < 4; ++ks) va[e * 4 + ks] = *(const LAS bf16x8*)(vp + e * 32 * AT_ROWB + 32 * ks);
#pragma unroll
    for (int e = 0; e < 2; ++e)
#pragma unroll
        for (int ks = 0; ks < 4; ++ks) vb[e * 4 + ks] = *(const LAS bf16x8*)(vp + (2 + e) * 32 * AT_ROWB + 32 * ks);
    const short one = (short)0x3F80; const bf16x8 ones = {one, one, one, one, one, one, one, one};
    __builtin_amdgcn_sched_barrier(0);
#pragma unroll
    for (int ks = 0; ks < 4; ++ks) L = MFMA32(ones, pf[ks], L);
    __builtin_amdgcn_sched_barrier(0);
#pragma unroll
    for (int ks = 0; ks < 4; ++ks) { O[0] = MFMA32(va[ks], pf[ks], O[0]); O[1] = MFMA32(va[4 + ks], pf[ks], O[1]); }
#pragma unroll
    for (int ks = 0; ks < 4; ++ks) { O[2] = MFMA32(vb[ks], pf[ks], O[2]); O[3] = MFMA32(vb[4 + ks], pf[ks], O[3]); }
}

__device__ __forceinline__ void attn_item(LAS unsigned char* lds, const bf16_t* Q, const bf16_t* Kb, const bf16_t* VT, bf16_t* aout, const float* subg, float lam, float omli, float kbound, int head, int qb) {
    int tid_ = threadIdx.x; asm volatile("" : "+v"(tid_));
    const int tid = tid_, lane = tid & 63, r = lane & 31, hh = lane >> 5; const int wid = __builtin_amdgcn_readfirstlane(tid >> 6);
    const int comp = wid >> 2, qt = wid & 3; const int q0 = qb * 128 + qt * 32, q = q0 + r; const int nt = 2 * qb + 2;
    bf16x8 qf[4];
    { const bf16_t* Qp = Q + ((size_t)(head * 2 + comp) * S + q) * 64 + 8 * hh;
#pragma unroll
      for (int s = 0; s < 4; ++s) qf[s] = *(const bf16x8*)(Qp + 16 * s); }
    const int srow = tid >> 3, sch = tid & 7;
    const char* bK1 = (const char*)(Kb + (size_t)(head * 2 + 0) * S * 64); const char* bK2 = (const char*)(Kb + (size_t)(head * 2 + 1) * S * 64);
    const char* bV0 = (const char*)(VT + (size_t)head * 256 * 128 * 64); const char* bV1 = bV0 + 8192;
    const unsigned koff = srow * 128 + sch * 16, voff = koff;
    const unsigned dK1 = srow * AT_ROWB + sch * 16, dK2 = AT_K2 + dK1, dV0 = AT_VOFF + dK1, dV1 = AT_VOFF + 64 * AT_ROWB + dK1;
    u32x4 ks0 = *(const u32x4*)(bK1 + koff), ks1 = *(const u32x4*)(bK2 + koff), vs0 = *(const u32x4*)(bV0 + voff), vs1 = *(const u32x4*)(bV1 + voff);
    *(LAS u32x4*)(lds + dK1) = ks0; *(LAS u32x4*)(lds + dK2) = ks1; *(LAS u32x4*)(lds + dV0) = vs0; *(LAS u32x4*)(lds + dV1) = vs1;
    ks0 = *(const u32x4*)(bK1 + 8192 + koff); ks1 = *(const u32x4*)(bK2 + 8192 + koff);
    asm volatile("" : "+v"(qf[0]), "+v"(qf[1]), "+v"(qf[2]), "+v"(qf[3]));
    __syncthreads();
    f32x16 O[4];
#pragma unroll
    for (int e = 0; e < 4; ++e)
#pragma unroll
        for (int i = 0; i < 16; ++i) O[e][i] = 0.f;
    float qn2 = 0.f;
#pragma unroll
    for (int s = 0; s < 4; ++s)
#pragma unroll
        for (int e = 0; e < 8; ++e) { const float v = bf2f((bf16_t)qf[s][e]); qn2 += v * v; }
    const float sbound = __builtin_sqrtf(half_swap_sum(qn2)) * kbound;
    const bool online = __builtin_amdgcn_ballot_w64(!(sbound <= 100.f)) != 0ull;
    float mrun = 0.f;
    f32x16 L;
#pragma unroll
    for (int i = 0; i < 16; ++i) L[i] = 0.f;
    bf16x8 pf[4];
#pragma unroll
    for (int i = 0; i < 4; ++i) pf[i] = (bf16x8){0, 0, 0, 0, 0, 0, 0, 0};
    const unsigned kfo = comp * AT_K2 + r * AT_ROWB + 16 * hh, vfo = AT_VOFF + r * AT_ROWB + 16 * hh;
    const int qmax = q0 + 31, ntm1 = nt - 1;
#define AT_ISSUE_V(jn) do { const int jc_ = (jn) < ntm1 ? (jn) : ntm1; const size_t vo_ = (size_t)jc_ * 16384; vs0 = *(const u32x4*)(bV0 + vo_ + voff); vs1 = *(const u32x4*)(bV1 + vo_ + voff); } while (0)
#define AT_ISSUE_K(jn) do { const int jc_ = (jn) < ntm1 ? (jn) : ntm1; const size_t ko_ = (size_t)jc_ * 8192; ks0 = *(const u32x4*)(bK1 + ko_ + koff); ks1 = *(const u32x4*)(bK2 + ko_ + koff); } while (0)
#define AT_WRITE_K(jn) do { LAS unsigned char* n_ = lds + ((jn) & 1) * AT_KST; *(LAS u32x4*)(n_ + dK1) = ks0; *(LAS u32x4*)(n_ + dK2) = ks1; } while (0)
#define AT_WRITE_V(jn) do { LAS unsigned char* n_ = lds + ((jn) & 1) * AT_KST; *(LAS u32x4*)(n_ + dV0) = vs0; *(LAS u32x4*)(n_ + dV1) = vs1; } while (0)
    if (comp == 0) {
        for (int j = 0; j < nt; ++j) {
            const LAS unsigned char* stg = lds + (j & 1) * AT_KST; const int kbase = j * 64; const bool act = kbase <= qmax;
            __builtin_amdgcn_s_setprio(3);
            AT_ISSUE_V(j + 1);
            if (act) at_qk_half(online, stg + kfo, qf, q, q0, kbase, hh, mrun, O, L, pf);
            __builtin_amdgcn_s_setprio(3);
            AT_WRITE_K(j + 1);
            __syncthreads();
            __builtin_amdgcn_s_setprio(0);
            AT_ISSUE_K(j + 2);
            if (act) at_pv_half(stg + vfo, pf, O, L);
            AT_WRITE_V(j + 1);
            __syncthreads();
        }
        __syncthreads();
    } else {
        for (int j = 0; j < nt; ++j) {
            const LAS unsigned char* stg = lds + (j & 1) * AT_KST; const LAS unsigned char* pst = lds + ((j + 1) & 1) * AT_KST; const int kbase = j * 64;
            AT_ISSUE_V(j + 1);
            if (j > 0 && kbase - 64 <= qmax) at_pv_half(pst + vfo, pf, O, L);
            AT_WRITE_K(j + 1);
            __syncthreads();
            __builtin_amdgcn_s_setprio(3);
            AT_ISSUE_K(j + 2);
            if (kbase <= qmax) at_qk_half(online, stg + kfo, qf, q, q0, kbase, hh, mrun, O, L, pf);
            __builtin_amdgcn_s_setprio(3);
            AT_WRITE_V(j + 1);
            __syncthreads();
            __builtin_amdgcn_s_setprio(0);
        }
        if ((nt - 1) * 64 <= qmax) at_pv_half(lds + ((nt - 1) & 1) * AT_KST + vfo, pf, O, L);
        __syncthreads();
    }
#undef AT_ISSUE_V
#undef AT_ISSUE_K
#undef AT_WRITE_K
#undef AT_WRITE_V
    const float inv = 1.f / L[0];
    LAS float* X = (LAS float*)lds;
    if (comp == 1) {
#pragma unroll
        for (int e = 0; e < 4; ++e)
#pragma unroll
            for (int i = 0; i < 16; ++i) X[(qt * 128 + 32 * e + (i & 3) + 8 * (i >> 2) + 4 * hh) * 32 + r] = O[e][i] * inv;
    }
    __syncthreads();
    if (comp == 0) {
        float ss = 0.f;
#pragma unroll
        for (int e = 0; e < 4; ++e)
#pragma unroll
            for (int i = 0; i < 16; ++i) { const float o = O[e][i] * inv - lam * X[(qt * 128 + 32 * e + (i & 3) + 8 * (i >> 2) + 4 * hh) * 32 + r]; O[e][i] = o; ss += o * o; }
        ss = half_swap_sum(ss);
        const float rn = __builtin_amdgcn_rsqf(ss * (1.f / 128.f) + EPS) * omli;
        bf16_t* ap = aout + (size_t)q * 1024 + head * 128 + 4 * hh;
#pragma unroll
        for (int e = 0; e < 4; ++e)
#pragma unroll
            for (int g4 = 0; g4 < 4; ++g4) { const int e0 = 32 * e + 8 * g4; const f32x4 sg = *(const f32x4*)(subg + e0 + 4 * hh);
                u32x2 w; w.x = pk2(O[e][4 * g4 + 0] * rn * sg[0], O[e][4 * g4 + 1] * rn * sg[1]); w.y = pk2(O[e][4 * g4 + 2] * rn * sg[2], O[e][4 * g4 + 3] * rn * sg[3]);
                *(u32x2*)(ap + e0) = w; }
    }
    __syncthreads();
}

__device__ __forceinline__ void attn_phase(LAS unsigned char* lds, const bf16_t* Q, const bf16_t* Kb, const bf16_t* VT, bf16_t* aout, const float* subg, const float* lp, const float* kgain, float lam_init) {
    int tid_ = threadIdx.x; asm volatile("" : "+v"(tid_));
    const int lane = tid_ & 63;
    const float d01 = wave_sum(lp[lane] * lp[64 + lane]), d23 = wave_sum(lp[128 + lane] * lp[192 + lane]);
    const float lam = __expf(d01) - __expf(d23) + lam_init, omli = 1.f - lam_init;
    float kg = fabsf(kgain[lane]);
#pragma unroll
    for (int o = 1; o < 64; o <<= 1) kg = fmaxf(kg, __shfl_xor(kg, o));
    const float kbound = 8.f * kg * 1.0079f;
    for (int it = blockIdx.x; it < 256; it += gridDim.x) {
        const int head = (it & 7) >> 1, pi = ((it >> 3) << 1) | (it & 1);
        attn_item(lds, Q, Kb, VT, aout, subg, lam, omli, kbound, head, 127 - pi);
        attn_item(lds, Q, Kb, VT, aout, subg, lam, omli, kbound, head, pi);
    }
}


#define XB_TMO      128
#define XB_XCNT(j)  (256  + 64 * (j))
#define XB_XSUB(j)  (1280 + 64 * (j))
#define XB_XGEN(j)  (2304 + 64 * (j))
#define XB_TOP      3328
#define XB_TOPGEN   3392
#define XCD_BAR_WORDS 3456
#define XB_SPIN_CAP (1u << 18)
__device__ __forceinline__ unsigned xb_ld(unsigned* p)              { return __hip_atomic_load(p, __ATOMIC_RELAXED, __HIP_MEMORY_SCOPE_AGENT); }
__device__ __forceinline__ unsigned xb_add(unsigned* p, unsigned v) { return __hip_atomic_fetch_add(p, v, __ATOMIC_RELAXED, __HIP_MEMORY_SCOPE_AGENT); }
__device__ __forceinline__ unsigned xb_xcc_id() { return (unsigned)__builtin_amdgcn_s_getreg((3 << 11) | 20) & 0xFu; }
#define XB_SPIN(cond, bar) do { unsigned _sp = 0; while (cond) { __builtin_amdgcn_s_sleep(1); \
    if ((++_sp & 255u) == 0u) { if (xb_ld(&(bar)[XB_TMO])) break; if (_sp > XB_SPIN_CAP) { atomicAdd(&(bar)[XB_TMO], 1u); break; } } } } while (0)
struct XcdBarrier { unsigned* bar; unsigned x; volatile LAS unsigned* st; };
__device__ __forceinline__ XcdBarrier xcd_barrier_post(unsigned* bar, volatile LAS unsigned* st) {
    XcdBarrier b; b.bar = bar; b.x = xb_xcc_id(); b.st = st;
    if (threadIdx.x == 0) (void)xb_add(&bar[XB_XCNT(b.x)], 1u);
    return b;
}
__device__ __forceinline__ void xcd_barrier_complete(unsigned* bar, unsigned x, unsigned& nloc, unsigned& nx) {
    const unsigned G = gridDim.x * gridDim.y * gridDim.z;
    unsigned sum, cnt, mine, sp = 0u;
    for (;;) {
        sum = 0u; cnt = 0u; mine = 0u;
#pragma unroll
        for (unsigned j = 0; j < 16; ++j) { const unsigned c = xb_ld(&bar[XB_XCNT(j)]); sum += c; cnt += (c > 0u) ? 1u : 0u; mine = (j == x) ? c : mine; }
        if (sum == G) break;
        __builtin_amdgcn_s_sleep(1);
        if ((++sp & 255u) == 0u) { if (xb_ld(&bar[XB_TMO])) break; if (sp > XB_SPIN_CAP) { atomicAdd(&bar[XB_TMO], 1u); break; } }
    }
    nloc = mine > 0u ? mine : 1u; nx = cnt > 0u ? cnt : 1u;
}
__device__ __forceinline__ void xcd_barrier(const XcdBarrier& b) {
    asm volatile("s_waitcnt vmcnt(0)" ::: "memory");
    __syncthreads();
    if (threadIdx.x == 0) {
        unsigned* bar = b.bar;
        __builtin_amdgcn_s_waitcnt(0);
        unsigned nloc = b.st[0], nx = b.st[1];
        if (nloc == 0u) { xcd_barrier_complete(bar, b.x, nloc, nx); b.st[0] = nloc; b.st[1] = nx; }
        const unsigned old = xb_add(&bar[XB_XSUB(b.x)], 1u);
        const unsigned gen = old / nloc;
        if (old + 1u == (gen + 1u) * nloc) {
            __builtin_amdgcn_fence(__ATOMIC_RELEASE, "agent");
            asm volatile("s_waitcnt vmcnt(0)" ::: "memory");
            const unsigned og = xb_add(&bar[XB_TOP], 1u);
            const unsigned tg = og / nx;
            if (og + 1u == (tg + 1u) * nx) xb_add(&bar[XB_TOPGEN], 1u);
            else XB_SPIN(xb_ld(&bar[XB_TOPGEN]) == tg, bar);
            __builtin_amdgcn_fence(__ATOMIC_ACQUIRE, "agent");
            xb_add(&bar[XB_XGEN(b.x)], 1u);
            asm volatile("s_waitcnt vmcnt(0)" ::: "memory");
        } else {
            XB_SPIN(xb_ld(&bar[XB_XGEN(b.x)]) == gen, bar);
            __builtin_amdgcn_fence(__ATOMIC_ACQUIRE, "agent");
            asm volatile("s_waitcnt vmcnt(0)" ::: "memory");
        }
    }
    __syncthreads();
}

__global__ void __launch_bounds__(512, 2) mk_fwd(Params p) {
    extern __shared__ __attribute__((aligned(16))) unsigned char lds_raw[];
    LAS unsigned char* lds = (LAS unsigned char*)lds_raw;
    cg::grid_group grid = cg::this_grid();
#define FRESH() int G = gridDim.x, bid = blockIdx.x; size_t wz_ = 0; asm volatile("" : "+s"(G), "+s"(bid), "+s"(wz_)); unsigned char* ws = p.ws + wz_
    XcdBarrier gbar;
    { FRESH(); (void)G;
      unsigned* barw = (unsigned*)(ws + WS_BAR);
      volatile LAS unsigned* bst = (volatile LAS unsigned*)(lds + 131072);
      if (threadIdx.x < 2) bst[threadIdx.x] = 0u;
      if (bid == 0) for (int i = threadIdx.x; i < XCD_BAR_WORDS; i += 512) barw[i] = 0u;
      gbar.bar = barw; gbar.x = 0; gbar.st = bst; }
#pragma unroll 1
    for (int l = 0; l < DEPTH; ++l) {
        const float lam_init = 0.8f - 0.6f * __expf(-0.3f * (float)l);
        prep_phase(p, l, lds);
        if (l == 0) { grid.sync(); gbar = xcd_barrier_post(gbar.bar, gbar.st); }
        else xcd_barrier(gbar);
        {
            FRESH(); float* ssq = (float*)(ws + WS_SSQ); bf16_t* xb = (bf16_t*)(ws + WS_XB);
            pg8::Gemm g{xb, (bf16_t*)(ws + WS_WIN), S, NIN, D}; pg8::StaticOrder So; So.init(S, NIN, G, bid);
            EpiInProj E{ssq, (bf16_t*)(ws + WS_Q), (bf16_t*)(ws + WS_K), (bf16_t*)(ws + WS_XP), (bf16_t*)(ws + WS_GATES), p.q_norm_g + l * 64, p.k_norm_g + l * 64, p.b_gate + l * 2048};
            pg8::gemm_phase<EpiInProj, pg8::StaticOrder, true, true>(lds, g, So, E);
            pg8::Gemm g2{(bf16_t*)(ws + WS_WV), xb, 512, S, D}; pg8::StaticOrder So2; So2.init(512, S, G, (bid + G / 2) % G);
            EpiVT E2{ssq, (bf16_t*)(ws + WS_VT)};
            pg8::gemm_phase<EpiVT, pg8::StaticOrder, true, true>(lds, g2, So2, E2);
        }
        xcd_barrier(gbar);
        {
            FRESH(); (void)G; (void)bid;
            pool_phase((const bf16_t*)(ws + WS_XP), (bf16_t*)(ws + WS_A));
            attn_phase(lds, (const bf16_t*)(ws + WS_Q), (const bf16_t*)(ws + WS_K), (const bf16_t*)(ws + WS_VT), (bf16_t*)(ws + WS_A), p.subln_g + l * 128, p.lam_params + l * 256, p.k_norm_g + l * 64, lam_init);
        }
        xcd_barrier(gbar);
        {
            FRESH(); pg8::StaticOrder So; So.init(S, D, G, bid);
            pg8::Gemm g{(bf16_t*)(ws + WS_A), (bf16_t*)(ws + WS_WUA), S, D, D}; EpiUp E{(const bf16_t*)(ws + WS_GATES), (bf16_t*)(ws + WS_MERGED)};
            pg8::gemm_phase<EpiUp, pg8::StaticOrder, true, true>(lds, g, So, E);
        }
        xcd_barrier(gbar);
        {
            FRESH(); pg8::StaticOrder So; So.init(S, D, G, bid);
            pg8::Gemm g{(bf16_t*)(ws + WS_MERGED), (bf16_t*)(ws + WS_WO), S, D, D};
            if (l == 0) { EpiResid<true, false> E{p.x, nullptr, (bf16_t*)(ws + WS_XB), (float*)(ws + WS_SSQ)}; pg8::gemm_phase<EpiResid<true, false>, pg8::StaticOrder, true, true>(lds, g, So, E); }
            else        { EpiResid<false, false> E{nullptr, nullptr, (bf16_t*)(ws + WS_XB), (float*)(ws + WS_SSQ)}; pg8::gemm_phase<EpiResid<false, false>, pg8::StaticOrder, true, true>(lds, g, So, E); }
        }
        xcd_barrier(gbar);
        {
            FRESH(); pg8::StaticOrder So; So.init(S, FF, G, bid);
            pg8::Gemm g{(bf16_t*)(ws + WS_XB), (bf16_t*)(ws + WS_W1), S, FF, D}; EpiMlpIn E{(float*)(ws + WS_SSQ), (bf16_t*)(ws + WS_U)};
            pg8::gemm_phase<EpiMlpIn, pg8::StaticOrder, true, true>(lds, g, So, E);
        }
        xcd_barrier(gbar);
        {
            FRESH(); pg8::StaticOrder So; So.init(S, D, G, bid);
            pg8::Gemm g{(bf16_t*)(ws + WS_U), (bf16_t*)(ws + WS_W2), S, D, FF};
            if (l + 1 < DEPTH) { EpiResid<false, false> E{nullptr, nullptr, (bf16_t*)(ws + WS_XB), (float*)(ws + WS_SSQ)}; pg8::gemm_phase<EpiResid<false, false>, pg8::StaticOrder, true, true>(lds, g, So, E); }
            else               { EpiResid<false, true> E{nullptr, p.out, (bf16_t*)(ws + WS_XB), nullptr}; pg8::gemm_phase<EpiResid<false, true>, pg8::StaticOrder, true, true>(lds, g, So, E); }
        }
        if (l + 1 < DEPTH) xcd_barrier(gbar);
    }
#undef FRESH
}

extern "C" void kernel_launch(void* const* d_in, const int* in_sizes, int n_in, void* d_out, int out_size, void* d_ws, size_t ws_size, hipStream_t stream) {
    static int grid_blocks = 0;
    if (grid_blocks == 0) {
        if (n_in != 16 || out_size != S * D || ws_size < WS_END) { fprintf(stderr, "kernel_launch: unexpected shapes (n_in %d, out %d, ws %zu)\n", n_in, out_size, ws_size); grid_blocks = -1; return; }
        int dev = 0, cus = 0, per_cu = 0;
        hipGetDevice(&dev); hipDeviceGetAttribute(&cus, hipDeviceAttributeMultiprocessorCount, dev);
        if (hipFuncSetAttribute((const void*)mk_fwd, hipFuncAttributeMaxDynamicSharedMemorySize, LDS_BYTES) != hipSuccess) { fprintf(stderr, "kernel_launch: hipFuncSetAttribute failed\n"); grid_blocks = -1; return; }
        if (hipOccupancyMaxActiveBlocksPerMultiprocessor(&per_cu, (const void*)mk_fwd, 512, LDS_BYTES) != hipSuccess || per_cu < 1) { fprintf(stderr, "kernel_launch: occupancy query says %d blocks per CU\n", per_cu); per_cu = 1; }
        (void)hipGetLastError();
        grid_blocks = cus;
    }
    if (grid_blocks < 0) return;
    Params p{};
    const float** pp = (const float**)&p;
    for (int i = 0; i < 16; ++i) pp[i] = (const float*)d_in[i];
    p.out = (float*)d_out; p.ws = (unsigned char*)d_ws;
    void* args[] = {&p};
    hipError_t e = hipLaunchCooperativeKernel((const void*)mk_fwd, dim3(grid_blocks), dim3(512), args, LDS_BYTES, stream);
    if (e != hipSuccess) fprintf(stderr, "cooperative launch failed: %s (grid %d)\n", hipGetErrorString(e), grid_blocks);
}
```

```cpp
#include <hip/hip_runtime.h>
#include <hip/hip_cooperative_groups.h>
#include <cstdio>
#include <cstdint>
#include <cmath>
namespace cg = cooperative_groups;
namespace pg8 {
#define PG8_LAS __attribute__((address_space(3)))
typedef unsigned short bf16_t;
typedef short bf16x8 __attribute__((ext_vector_type(8)));
typedef float f32x4 __attribute__((ext_vector_type(4)));
typedef unsigned u32x4 __attribute__((ext_vector_type(4)));
constexpr int BM = 256, BK = 64, HALF = 128, HTB = HALF * BK * 2  , STAGE_BYTES = 8 * HTB, NXCD = 8, WGM = 8;

__host__ __device__ __forceinline__ int lds_byte(int r, int c) { const int st = (r >> 4) * 2 + (c >> 5), rr = r & 15, cc = c & 31, ob = rr * 64 + cc * 2; return st * 1024 + (ob ^ (((ob >> 9) & 1) << 5)); }
__host__ __device__ __forceinline__ void stage_rc(int b, int& R, int& C) { const int st = b / 1024, sb = b % 1024, swz = sb ^ (((sb >> 9) & 1) << 5); R = (st >> 1) * 16 + swz / 64; C = (st & 1) * 32 + (swz % 64) / 2; }
__host__ __device__ __forceinline__ int perm32(int rho) { const int n = rho >> 4, i = rho & 15; return 8 * (i >> 2) + 4 * n + (i & 3); }

struct Unit { int pm, pn; };
struct Gemm { const bf16_t* A; const bf16_t* Bt; int M, N, K; };

struct StaticOrder {
    int nM, nN, nwg, G, c;
    __host__ __device__ void init(int M, int N, int G_, int c_) { nM = M / BM; nN = N / BM; nwg = nM * nN; G = G_; c = c_; }
    __host__ __device__ bool next(int i, Unit& u) const {
        const long L = (long)i * G + c; if (L >= nwg) return false;
        int wgid = (int)L; { const int q = nwg / NXCD, r = nwg % NXCD, xcd = wgid % NXCD, off = wgid / NXCD; wgid = (xcd < r ? xcd * (q + 1) : r * (q + 1) + (xcd - r) * q) + off; }
        const int nig = WGM * nN, gid = wgid / nig, fm = gid * WGM, gsz = (nM - fm) < WGM ? (nM - fm) : WGM;
        u.pm = fm + ((wgid % nig) % gsz); u.pn = (wgid % nig) / gsz; return true;
    }
    __device__ __forceinline__ void a_ready(const Unit&) const {}
    __device__ __forceinline__ void done(const Unit&) const {}
};

template <class Epi, class Sched, bool ALIGN_EPI = false, bool SP2 = false>
__device__ __forceinline__ void gemm_phase(PG8_LAS unsigned char* lds, const Gemm g, const Sched& S, const Epi& E) {
    int tid_ = threadIdx.x; asm volatile("" : "+v"(tid_));
    const int tid = tid_, wid = __builtin_amdgcn_readfirstlane(tid >> 6), lane = tid & 63, wr = wid >> 2, wc = wid & 3, fr = lane & 15, fq = lane >> 4;
    const int K = g.K, nt = K / BK;
    unsigned voffA[2], voffB[2];
#pragma unroll
    for (int i = 0; i < 2; ++i) { int R, C; stage_rc(tid * 16 + i * 8192, R, C); const int Rb = Epi::PERM ? ((R & ~31) + perm32(R & 31)) : R;
        voffA[i] = (unsigned)(R * K + C) * 2u; voffB[i] = (unsigned)(Rb * K + C) * 2u; }
    const size_t kstep = (size_t)(BK * 2);
    const size_t hstep = (size_t)HALF * K * 2;
    const size_t tstep = 2 * hstep;
    const unsigned ldsw = (unsigned)wid * 1024u;
    const int aoff = lds_byte(wr * 64 + fr, fq * 8), boff = lds_byte(wc * 32 + fr, fq * 8);
#define PG8_SA(b, h) (((b) * 2 + (h)) * HTB)
#define PG8_SB(b, h) ((4 + (b) * 2 + (h)) * HTB)
#define PG8_STAGE(bufoff, gbase, voff) do { _Pragma("unroll") for (int _i = 0; _i < 2; ++_i) \
        __builtin_amdgcn_global_load_lds((const unsigned*)((const char*)(gbase) + (voff)[_i]), (PG8_LAS unsigned*)(lds + (bufoff) + ldsw + _i * 8192), 16, 0, 0); } while (0)
#define PG8_LDA(dst, b, h) do { _Pragma("unroll") for (int m = 0; m < 4; ++m) _Pragma("unroll") for (int k = 0; k < 2; ++k) dst[m][k] = *(const PG8_LAS bf16x8*)(lds + PG8_SA(b, h) + aoff + m * 2048 + k * 1024); } while (0)
#define PG8_LDB(dst, b, h) do { _Pragma("unroll") for (int n = 0; n < 2; ++n) _Pragma("unroll") for (int k = 0; k < 2; ++k) dst[n][k] = *(const PG8_LAS bf16x8*)(lds + PG8_SB(b, h) + boff + n * 2048 + k * 1024); } while (0)
#define PG8_MMA(ai, bj, At, Bt) do { __builtin_amdgcn_s_setprio(1); _Pragma("unroll") for (int m = 0; m < 4; ++m) _Pragma("unroll") for (int n = 0; n < 2; ++n) _Pragma("unroll") for (int k = 0; k < 2; ++k) \
        acc[ai][bj][m][n] = __builtin_amdgcn_mfma_f32_16x16x32_bf16(Bt[n][k], At[m][k], acc[ai][bj][m][n], 0, 0, 0); __builtin_amdgcn_s_setprio(0); } while (0)
#define PG8_WAIT_V(n) asm volatile("s_waitcnt vmcnt(" #n ")" ::: "memory")
#define PG8_WAIT_L(n) asm volatile("s_waitcnt lgkmcnt(" #n ")" ::: "memory")
#define PG8_BAR __builtin_amdgcn_s_barrier()
#define PG8_SCHED __builtin_amdgcn_sched_barrier(0)
    Unit cur, nxt; int ui = 0;
    if (!S.next(0, cur)) return;
    f32x4 acc[2][2][4][2];
#pragma unroll
    for (int a = 0; a < 2; ++a)
#pragma unroll
        for (int b = 0; b < 2; ++b)
#pragma unroll
            for (int m = 0; m < 4; ++m)
#pragma unroll
                for (int n = 0; n < 2; ++n) acc[a][b][m][n] = (f32x4){0.f, 0.f, 0.f, 0.f};
    bf16x8 At[4][2], B0[2][2], B1[2][2];
    const char* cA = (const char*)g.A + (size_t)cur.pm * tstep; const char* cB = (const char*)g.Bt + (size_t)cur.pn * tstep;
    S.a_ready(cur);
    if constexpr (SP2) {
        PG8_STAGE(PG8_SB(0, 0), cB, voffB); PG8_STAGE(PG8_SB(0, 1), cB + hstep, voffB); PG8_STAGE(PG8_SA(0, 0), cA, voffA); PG8_STAGE(PG8_SA(0, 1), cA + hstep, voffA);
        if (wr == 1) PG8_BAR;
        PG8_WAIT_V(2); PG8_BAR;
        PG8_STAGE(PG8_SB(1, 0), cB + kstep, voffB); PG8_STAGE(PG8_SA(1, 0), cA + kstep, voffA); PG8_STAGE(PG8_SB(1, 1), cB + hstep + kstep, voffB);
        PG8_WAIT_V(6); PG8_BAR;
    } else {
        PG8_STAGE(PG8_SB(0, 0), cB, voffB); PG8_STAGE(PG8_SA(0, 0), cA, voffA); PG8_STAGE(PG8_SB(0, 1), cB + hstep, voffB); PG8_STAGE(PG8_SA(0, 1), cA + hstep, voffA);
        if (wr == 1) PG8_BAR;
        PG8_WAIT_V(4); PG8_BAR;
        PG8_STAGE(PG8_SB(1, 0), cB + kstep, voffB); PG8_STAGE(PG8_SA(1, 0), cA + kstep, voffA); PG8_STAGE(PG8_SB(1, 1), cB + hstep + kstep, voffB);
        PG8_WAIT_V(6); PG8_BAR;
    }
    for (;;) {
        const bool has_next = S.next(ui + 1, nxt);
        const char* nA = has_next ? (const char*)g.A + (size_t)nxt.pm * tstep : cA; const char* nB = has_next ? (const char*)g.Bt + (size_t)nxt.pn * tstep : cB;
        for (int t = 0; t < nt; t += 2) {
            const bool last = (t == nt - 2);
            const char* a1 = cA + (size_t)(t + 1) * kstep;
            const char* a2 = last ? nA : cA + (size_t)(t + 2) * kstep; const char* b2 = last ? nB : cB + (size_t)(t + 2) * kstep;
            const char* a3 = a2 + kstep; const char* b3 = b2 + kstep;
            if (last && has_next) S.a_ready(nxt);
            if constexpr (SP2) {
            PG8_LDB(B0, 0, 0); PG8_LDB(B1, 0, 1); PG8_SCHED; PG8_LDA(At, 0, 0); PG8_STAGE(PG8_SA(1, 1), a1 + hstep, voffA);
            PG8_WAIT_V(8); PG8_WAIT_L(0); PG8_BAR; PG8_MMA(0, 0, At, B0); PG8_MMA(0, 1, At, B1); PG8_BAR; PG8_SCHED;
            PG8_LDA(At, 0, 1); PG8_STAGE(PG8_SB(0, 0), b2, voffB); PG8_STAGE(PG8_SB(0, 1), b2 + hstep, voffB); PG8_STAGE(PG8_SA(0, 0), a2, voffA);
            PG8_WAIT_V(8); PG8_WAIT_L(0); PG8_BAR; PG8_MMA(1, 0, At, B0); PG8_MMA(1, 1, At, B1); PG8_BAR; PG8_SCHED;
            PG8_LDB(B0, 1, 0); PG8_LDB(B1, 1, 1); PG8_SCHED; PG8_LDA(At, 1, 0); PG8_STAGE(PG8_SA(0, 1), a2 + hstep, voffA);
            PG8_WAIT_V(8); PG8_WAIT_L(0); PG8_BAR; PG8_MMA(0, 0, At, B0); PG8_MMA(0, 1, At, B1); PG8_BAR; PG8_SCHED;
            PG8_LDA(At, 1, 1); PG8_STAGE(PG8_SB(1, 0), b3, voffB); PG8_STAGE(PG8_SB(1, 1), b3 + hstep, voffB); PG8_STAGE(PG8_SA(1, 0), a3, voffA);
            PG8_WAIT_V(8); PG8_WAIT_L(0); PG8_BAR; PG8_MMA(1, 0, At, B0); PG8_MMA(1, 1, At, B1); PG8_BAR; PG8_SCHED;
            } else {
            PG8_LDB(B0, 0, 0); PG8_SCHED; PG8_LDA(At, 0, 0); PG8_STAGE(PG8_SA(1, 1), a1 + hstep, voffA);
            PG8_WAIT_L(8); PG8_BAR; PG8_WAIT_L(0); PG8_MMA(0, 0, At, B0); PG8_BAR; PG8_SCHED;
            PG8_LDB(B1, 0, 1); PG8_STAGE(PG8_SB(0, 0), b2, voffB);
            PG8_BAR; PG8_WAIT_L(0); PG8_MMA(0, 1, At, B1); PG8_BAR;
            PG8_LDA(At, 0, 1); PG8_STAGE(PG8_SA(0, 0), a2, voffA);
            PG8_BAR; PG8_WAIT_L(0); PG8_MMA(1, 0, At, B0); PG8_BAR; PG8_SCHED;
            PG8_STAGE(PG8_SB(0, 1), b2 + hstep, voffB);
            PG8_WAIT_V(6); PG8_BAR; PG8_MMA(1, 1, At, B1); PG8_BAR;
            PG8_LDB(B0, 1, 0); PG8_SCHED; PG8_LDA(At, 1, 0); PG8_STAGE(PG8_SA(0, 1), a2 + hstep, voffA);
            PG8_WAIT_L(8); PG8_BAR; PG8_WAIT_L(0); PG8_MMA(0, 0, At, B0); PG8_BAR; PG8_SCHED;
            PG8_LDB(B1, 1, 1); PG8_STAGE(PG8_SB(1, 0), b3, voffB);
            PG8_BAR; PG8_WAIT_L(0); PG8_MMA(0, 1, At, B1); PG8_BAR;
            PG8_LDA(At, 1, 1); PG8_STAGE(PG8_SA(1, 0), a3, voffA);
            PG8_BAR; PG8_WAIT_L(0); PG8_MMA(1, 0, At, B0); PG8_BAR; PG8_SCHED;
            PG8_STAGE(PG8_SB(1, 1), b3 + hstep, voffB);
            PG8_WAIT_V(6); PG8_BAR; PG8_MMA(1, 1, At, B1); PG8_BAR;
            }
            if constexpr (Epi::MID_HOOK) { if (t == Epi::MID_T) E.mid(acc, cur, wr, wc, fr, fq); }
        }
        if constexpr (ALIGN_EPI) { if (wr == 0) PG8_BAR; }
        if constexpr (!Epi::AFTER_DRAIN) { E(acc, cur, wr, wc, fr, fq); S.done(cur); }
        if (!has_next) break;
#pragma unroll
        for (int a = 0; a < 2; ++a)
#pragma unroll
            for (int b = 0; b < 2; ++b)
#pragma unroll
                for (int m = 0; m < 4; ++m)
#pragma unroll
                    for (int n = 0; n < 2; ++n) acc[a][b][m][n] = (f32x4){0.f, 0.f, 0.f, 0.f};
        cur = nxt; cA = nA; cB = nB; ++ui;
        if constexpr (ALIGN_EPI) { if (wr == 1) PG8_BAR; }
    }
    PG8_WAIT_V(0);
    if constexpr (!ALIGN_EPI) { if (wr == 0) PG8_BAR; }
    PG8_BAR;
    if constexpr (Epi::AFTER_DRAIN) { E.fused(acc, cur, wr, wc, fr, fq, lds, wid, lane); S.done(cur); }
#undef PG8_SA
#undef PG8_SB
#undef PG8_STAGE
#undef PG8_LDA
#undef PG8_LDB
#undef PG8_MMA
#undef PG8_WAIT_V
#undef PG8_WAIT_L
#undef PG8_BAR
#undef PG8_SCHED
}
}
#define LAS __attribute__((address_space(3)))
typedef unsigned short bf16_t;
typedef short bf16x8 __attribute__((ext_vector_type(8)));
typedef float f32x4 __attribute__((ext_vector_type(4)));
typedef float f32x2 __attribute__((ext_vector_type(2)));
typedef float f32x16 __attribute__((ext_vector_type(16)));
typedef unsigned u32x4 __attribute__((ext_vector_type(4)));
typedef unsigned u32x2 __attribute__((ext_vector_type(2)));
typedef __bf16 bf16x2_t __attribute__((ext_vector_type(2)));

constexpr int S = 16384, D = 1024, DEPTH = 4, NIN = 3584  , FF = 4096;
constexpr float EPS = 1e-6f;
constexpr float QSCALE = 0.125f * 1.4426950408889634f;
constexpr float LOG2E = 1.4426950408889634f;

__device__ __forceinline__ unsigned pk2(float lo, float hi) { f32x2 v = {lo, hi}; bf16x2_t b = __builtin_convertvector(v, bf16x2_t); return __builtin_bit_cast(unsigned, b); }
__device__ __forceinline__ float bf2f(bf16_t v) { return __uint_as_float(((unsigned)v) << 16); }
__device__ __forceinline__ bf16_t f2bf(float f) { return (bf16_t)(pk2(f, 0.f) & 0xffffu); }
__device__ __forceinline__ float wave_sum(float v) {
#pragma unroll
    for (int o = 1; o < 64; o <<= 1) v += __shfl_xor(v, o);
    return v;
}
__device__ __forceinline__ float half_swap_sum(float v) { auto rr = __builtin_amdgcn_permlane32_swap(__float_as_uint(v), __float_as_uint(v), false, false); return __uint_as_float(rr[0]) + __uint_as_float(rr[1]); }
__device__ __forceinline__ float half_swap_max(float v) { auto rr = __builtin_amdgcn_permlane32_swap(__float_as_uint(v), __float_as_uint(v), false, false); return fmaxf(__uint_as_float(rr[0]), __uint_as_float(rr[1])); }

__device__ __forceinline__ float row_rstd(const float* ssq, int row) {
    const f32x4* p = (const f32x4*)(ssq + (size_t)row * 16);
    const f32x4 a = p[0], b = p[1], c = p[2], d = p[3];
    const f32x4 s = (a + b) + (c + d);
    const float t = (s[0] + s[1]) + (s[2] + s[3]);
    return __builtin_amdgcn_rsqf(t * (1.f / 1024.f) + EPS);
}

using pg8::Unit;
typedef f32x4 acc_t[2][2][4][2];

struct EpiInProj {
    static constexpr bool PERM = true, AFTER_DRAIN = false, MID_HOOK = false; static constexpr int MID_T = -1;
    const float* ssq; bf16_t* Q; bf16_t* Kb; bf16_t* xp; bf16_t* gates; const float* qg; const float* kg; const float* bg;
    __device__ __forceinline__ void operator()(const acc_t& acc, const Unit& u, int wr, int wc, int fr, int fq) const {
        const int row0 = u.pm * 256 + wr * 64 + fr, pn = u.pn;
        if (pn < 4) {
            const bool isq = pn < 2; const float* g = isq ? qg : kg; const float sc = isq ? QSCALE : 1.f;
            bf16_t* base = (isq ? Q : Kb) + (size_t)((pn & 1) * 4 + wc) * S * 64;
            f32x4 gv[2][2];
#pragma unroll
            for (int bj = 0; bj < 2; ++bj)
#pragma unroll
                for (int n = 0; n < 2; ++n) gv[bj][n] = *(const f32x4*)(g + 32 * bj + 8 * fq + 4 * n) * sc;
#pragma unroll
            for (int ai = 0; ai < 2; ++ai)
#pragma unroll
                for (int m = 0; m < 4; ++m) {
                    const int row = row0 + ai * 128 + m * 16; const float rs = row_rstd(ssq, row);
                    f32x4 v[2][2]; float ss = 0.f;
#pragma unroll
                    for (int bj = 0; bj < 2; ++bj)
#pragma unroll
                        for (int n = 0; n < 2; ++n) { v[bj][n] = acc[ai][bj][m][n] * rs; const f32x4 q2 = v[bj][n] * v[bj][n]; ss += (q2[0] + q2[1]) + (q2[2] + q2[3]); }
                    ss += __shfl_xor(ss, 16); ss += __shfl_xor(ss, 32);
                    const float r2 = __builtin_amdgcn_rsqf(ss * (1.f / 64.f) + EPS);
#pragma unroll
                    for (int bj = 0; bj < 2; ++bj) { const f32x4 a = v[bj][0] * r2 * gv[bj][0], b = v[bj][1] * r2 * gv[bj][1];
                        u32x4 w; w.x = pk2(a[0], a[1]); w.y = pk2(a[2], a[3]); w.z = pk2(b[0], b[1]); w.w = pk2(b[2], b[3]);
                        *(u32x4*)(base + (size_t)row * 64 + 32 * bj + 8 * fq) = w; }
                }
        } else if (pn < 6) {
            const int col0 = (pn - 4) * 256 + wc * 32 + 8 * fq;
#pragma unroll
            for (int ai = 0; ai < 2; ++ai)
#pragma unroll
                for (int m = 0; m < 4; ++m) {
                    const int row = row0 + ai * 128 + m * 16; const float rs = row_rstd(ssq, row);
#pragma unroll
                    for (int bj = 0; bj < 2; ++bj) { const f32x4 a = acc[ai][bj][m][0] * rs, b = acc[ai][bj][m][1] * rs;
                        u32x4 w; w.x = pk2(a[0], a[1]); w.y = pk2(a[2], a[3]); w.z = pk2(b[0], b[1]); w.w = pk2(b[2], b[3]);
                        *(u32x4*)(xp + (size_t)row * 512 + col0 + bj * 128) = w; }
                }
        } else {
            const int col0 = (pn - 6) * 256 + wc * 32 + 8 * fq;
            f32x4 bv[2][2];
#pragma unroll
            for (int bj = 0; bj < 2; ++bj)
#pragma unroll
                for (int n = 0; n < 2; ++n) bv[bj][n] = *(const f32x4*)(bg + col0 + bj * 128 + 4 * n) * (-LOG2E);
#pragma unroll
            for (int ai = 0; ai < 2; ++ai)
#pragma unroll
                for (int m = 0; m < 4; ++m) {
                    const int row = row0 + ai * 128 + m * 16; const float rs = row_rstd(ssq, row) * (-LOG2E);
#pragma unroll
                    for (int bj = 0; bj < 2; ++bj) { f32x4 a = acc[ai][bj][m][0] * rs + bv[bj][0], b = acc[ai][bj][m][1] * rs + bv[bj][1];
#pragma unroll
                        for (int j = 0; j < 4; ++j) { a[j] = __builtin_amdgcn_rcpf(1.f + __builtin_amdgcn_exp2f(a[j])); b[j] = __builtin_amdgcn_rcpf(1.f + __builtin_amdgcn_exp2f(b[j])); }
                        u32x4 w; w.x = pk2(a[0], a[1]); w.y = pk2(a[2], a[3]); w.z = pk2(b[0], b[1]); w.w = pk2(b[2], b[3]);
                        *(u32x4*)(gates + (size_t)row * 2048 + col0 + bj * 128) = w; }
                }
        }
    }
};

struct EpiVT {
    static constexpr bool PERM = false, AFTER_DRAIN = false, MID_HOOK = false; static constexpr int MID_T = -1;
    const float* ssq; bf16_t* VT;
    __device__ __forceinline__ void operator()(const acc_t& acc, const Unit& u, int wr, int wc, int fr, int fq) const {
        const int f0 = u.pm * 256 + wr * 64 + fr; const int sfq = ((fq & 1) << 1) | (fq >> 1);
#pragma unroll
        for (int bj = 0; bj < 2; ++bj)
#pragma unroll
            for (int n = 0; n < 2; ++n) {
                const int tg = u.pn * 256 + bj * 128 + wc * 32 + n * 16; const int tok = tg + 4 * fq;
                f32x4 rs; rs[0] = row_rstd(ssq, tok); rs[1] = row_rstd(ssq, tok + 1); rs[2] = row_rstd(ssq, tok + 2); rs[3] = row_rstd(ssq, tok + 3);
#pragma unroll
                for (int ai = 0; ai < 2; ++ai)
#pragma unroll
                    for (int m = 0; m < 4; ++m) { const f32x4 v = acc[ai][bj][m][n] * rs; u32x2 w; w.x = pk2(v[0], v[1]); w.y = pk2(v[2], v[3]);
                        const int f = f0 + ai * 128 + m * 16;
                        *(u32x2*)(VT + ((size_t)((f >> 7) * 256 + (tg >> 6)) * 128 + (f & 127)) * 64 + (tg & 63) + 4 * sfq) = w; }
            }
    }
};

struct EpiUp {
    static constexpr bool PERM = true, AFTER_DRAIN = false, MID_HOOK = true; static constexpr int MID_T = 6;
    const bf16_t* gates; bf16_t* merged;
    static __device__ __forceinline__ void unpack8(const u32x4 w, f32x4& a, f32x4& b) {
        a[0] = __uint_as_float(w.x << 16); a[1] = __uint_as_float(w.x & 0xffff0000u); a[2] = __uint_as_float(w.y << 16); a[3] = __uint_as_float(w.y & 0xffff0000u);
        b[0] = __uint_as_float(w.z << 16); b[1] = __uint_as_float(w.z & 0xffff0000u); b[2] = __uint_as_float(w.w << 16); b[3] = __uint_as_float(w.w & 0xffff0000u);
    }
    __device__ __forceinline__ void mid(acc_t& acc, const Unit& u, int, int, int, int) const {
        int tid = threadIdx.x; asm volatile("" : "+v"(tid));
        const int wid = tid >> 6, lane = tid & 63, wr = wid >> 2, wc = wid & 3, fr = lane & 15, fq = lane >> 4;
        const int row0 = u.pm * 256 + wr * 64 + fr, col0 = u.pn * 256 + wc * 32 + 8 * fq;
#pragma unroll
        for (int ai = 0; ai < 2; ++ai)
#pragma unroll
            for (int m = 0; m < 4; ++m) { const bf16_t* gr = gates + (size_t)(row0 + ai * 128 + m * 16) * 2048 + col0;
#pragma unroll
                for (int bj = 0; bj < 2; ++bj) { f32x4 a0, a1, b0, b1; unpack8(*(const u32x4*)(gr + bj * 128), a0, a1); unpack8(*(const u32x4*)(gr + 1024 + bj * 128), b0, b1);
#pragma unroll
                    for (int j = 0; j < 4; ++j) { a0[j] *= __builtin_amdgcn_rcpf(fmaxf(b0[j], 1e-20f)); a1[j] *= __builtin_amdgcn_rcpf(fmaxf(b1[j], 1e-20f)); }
                    acc[ai][bj][m][0] *= a0; acc[ai][bj][m][1] *= a1; }
                asm volatile("" ::: "memory"); }
    }
    __device__ __forceinline__ void operator()(const acc_t& acc, const Unit& u, int wr, int wc, int fr, int fq) const {
        const int row0 = u.pm * 256 + wr * 64 + fr, col0 = u.pn * 256 + wc * 32 + 8 * fq;
#pragma unroll
        for (int ai = 0; ai < 2; ++ai)
#pragma unroll
            for (int m = 0; m < 4; ++m) { const int row = row0 + ai * 128 + m * 16; const bf16_t* gr = gates + (size_t)row * 2048 + 1024 + col0;
#pragma unroll
                for (int bj = 0; bj < 2; ++bj) { f32x4 b0, b1; unpack8(*(const u32x4*)(gr + bj * 128), b0, b1);
#pragma unroll
                    for (int j = 0; j < 4; ++j) { b0[j] = fmaxf(b0[j], 1e-20f); b1[j] = fmaxf(b1[j], 1e-20f); }
                    const f32x4 a = acc[ai][bj][m][0] * b0, b = acc[ai][bj][m][1] * b1;
                    u32x4 w; w.x = pk2(a[0], a[1]); w.y = pk2(a[2], a[3]); w.z = pk2(b[0], b[1]); w.w = pk2(b[2], b[3]);
                    *(u32x4*)(merged + (size_t)row * 1024 + col0 + bj * 128) = w; } }
    }
};
template <bool IN_F32, bool OUT_F32>
struct EpiResid {
    static constexpr bool PERM = false, AFTER_DRAIN = false, MID_HOOK = false; static constexpr int MID_T = -1;
    const float* xin; float* xout; bf16_t* xb; float* ssq;
    __device__ __forceinline__ void operator()(const acc_t& acc, const Unit& u, int wr, int wc, int fr, int fq) const {
        const int row0 = u.pm * 256 + wr * 64 + fr, col0 = u.pn * 256 + wc * 32 + 4 * fq;
#pragma unroll
        for (int ai = 0; ai < 2; ++ai) {
            f32x4 xv[4][2][2];
#pragma unroll
            for (int m = 0; m < 4; ++m)
#pragma unroll
                for (int bj = 0; bj < 2; ++bj)
#pragma unroll
                    for (int n = 0; n < 2; ++n) { const size_t off = (size_t)(row0 + ai * 128 + m * 16) * 1024 + col0 + bj * 128 + n * 16;
                        if (IN_F32) xv[m][bj][n] = *(const f32x4*)(xin + off);
                        else { const u32x2 h = *(const u32x2*)(xb + off);
                            xv[m][bj][n][0] = __uint_as_float(h.x << 16); xv[m][bj][n][1] = __uint_as_float(h.x & 0xffff0000u); xv[m][bj][n][2] = __uint_as_float(h.y << 16); xv[m][bj][n][3] = __uint_as_float(h.y & 0xffff0000u); } }
#pragma unroll
            for (int m = 0; m < 4; ++m) { const int row = row0 + ai * 128 + m * 16; float ss = 0.f;
#pragma unroll
                for (int bj = 0; bj < 2; ++bj)
#pragma unroll
                    for (int n = 0; n < 2; ++n) { const size_t off = (size_t)row * 1024 + col0 + bj * 128 + n * 16;
                        const f32x4 v = xv[m][bj][n] + acc[ai][bj][m][n];
                        if (OUT_F32) *(f32x4*)(xout + off) = v;
                        else { u32x2 w; w.x = pk2(v[0], v[1]); w.y = pk2(v[2], v[3]); *(u32x2*)(xb + off) = w;
                            const f32x4 q2 = v * v; ss += (q2[0] + q2[1]) + (q2[2] + q2[3]); } }
                if (!OUT_F32) { ss += __shfl_xor(ss, 16); ss += __shfl_xor(ss, 32);
                    if (fq == 0) ssq[(size_t)row * 16 + u.pn * 4 + wc] = ss; } }
        }
    }
};
struct EpiMlpIn {
    static constexpr bool PERM = true, AFTER_DRAIN = false, MID_HOOK = false; static constexpr int MID_T = -1;
    const float* ssq; bf16_t* U;
    __device__ __forceinline__ void operator()(const acc_t& acc, const Unit& u, int wr, int wc, int fr, int fq) const {
        const int row0 = u.pm * 256 + wr * 64 + fr, col0 = u.pn * 256 + wc * 32 + 8 * fq;
#pragma unroll
        for (int ai = 0; ai < 2; ++ai)
#pragma unroll
            for (int m = 0; m < 4; ++m) { const int row = row0 + ai * 128 + m * 16; const float rs = row_rstd(ssq, row);
#pragma unroll
                for (int bj = 0; bj < 2; ++bj) { f32x4 a = acc[ai][bj][m][0] * rs, b = acc[ai][bj][m][1] * rs;
#pragma unroll
                    for (int j = 0; j < 4; ++j) { a[j] = fmaxf(a[j], 0.f); a[j] *= a[j]; b[j] = fmaxf(b[j], 0.f); b[j] *= b[j]; }
                    u32x4 w; w.x = pk2(a[0], a[1]); w.y = pk2(a[2], a[3]); w.z = pk2(b[0], b[1]); w.w = pk2(b[2], b[3]);
                    *(u32x4*)(U + (size_t)row * FF + col0 + bj * 128) = w; } }
    }
};
constexpr size_t MiB = 1u << 20;
constexpr size_t WS_SSQ = 0;
constexpr size_t WS_WIN = 1 * MiB, WS_WV = 8 * MiB, WS_WUA = 9 * MiB, WS_WPP = 10 * MiB, WS_WO = 11 * MiB, WS_W1 = 13 * MiB, WS_W2 = 21 * MiB;
constexpr size_t WS_BAR = 29 * MiB;
constexpr size_t WS_XB = 32 * MiB;
constexpr size_t WS_Q = 64 * MiB, WS_K = 80 * MiB, WS_VT = 96 * MiB, WS_XP = 112 * MiB, WS_GATES = 128 * MiB;
constexpr size_t WS_U = 64 * MiB;
constexpr size_t WS_A = 192 * MiB  , WS_MERGED = 224 * MiB, WS_END = 256 * MiB;
constexpr int LDS_BYTES = 131072 + 1024;

__device__ __forceinline__ void transpose_item(const float* W, int ldw, int Kd, const float* gk, bf16_t* WTrow0, int k0, int n0, LAS float* scr, int lane) {
    float tv[32];
#pragma unroll
    for (int i = 0; i < 32; ++i) tv[i] = W[(size_t)(k0 + 2 * i + (lane >> 5)) * ldw + n0 + (lane & 31)];
    if (gk) {
        float gvv[32];
#pragma unroll
        for (int i = 0; i < 32; ++i) gvv[i] = gk[k0 + 2 * i + (lane >> 5)];
#pragma unroll
        for (int i = 0; i < 32; ++i) tv[i] *= gvv[i];
    }
#pragma unroll
    for (int i = 0; i < 32; ++i) scr[(2 * i + (lane >> 5)) * 33 + (lane & 31)] = tv[i];
    asm volatile("s_waitcnt lgkmcnt(0)" ::: "memory");
    const int c = lane & 7;
#pragma unroll
    for (int j = 0; j < 4; ++j) { const int n = (lane >> 3) + 8 * j; const LAS float* s = scr + (8 * c) * 33 + n;
        u32x4 o; o.x = pk2(s[0 * 33], s[1 * 33]); o.y = pk2(s[2 * 33], s[3 * 33]); o.z = pk2(s[4 * 33], s[5 * 33]); o.w = pk2(s[6 * 33], s[7 * 33]);
        *(u32x4*)(WTrow0 + (size_t)n * Kd + k0 + 8 * c) = o; }
    asm volatile("s_waitcnt lgkmcnt(0)" ::: "memory");
}

struct Params {
    const float *x, *norm1_g, *w_in, *b_gate, *q_norm_g, *k_norm_g, *lam_params, *subln_g, *pool_w, *pool_scale, *w_up_attn, *w_up_pool, *w_o, *norm2_g, *w_mlp_in, *w_mlp_out;
    float* out; unsigned char* ws;
};

__device__ __forceinline__ void prep_phase(const Params& p, int l, LAS unsigned char* lds) {
    int tid_ = threadIdx.x; asm volatile("" : "+v"(tid_));
    const int lane = tid_ & 63, wave = __builtin_amdgcn_readfirstlane(tid_ >> 6);
    LAS float* scr = (LAS float*)(lds + wave * 16384);
    const int gw = blockIdx.x * 8 + wave, NGW = gridDim.x * 8;
    unsigned char* ws = p.ws;
    bf16_t* WinT = (bf16_t*)(ws + WS_WIN); bf16_t* WvT = (bf16_t*)(ws + WS_WV); bf16_t* WuaT = (bf16_t*)(ws + WS_WUA);
    bf16_t* WoT = (bf16_t*)(ws + WS_WO); bf16_t* W1T = (bf16_t*)(ws + WS_W1); bf16_t* W2T = (bf16_t*)(ws + WS_W2);
    const float* w_in = p.w_in + (size_t)l * D * 4096; const float* g1 = p.norm1_g + l * D; const float* g2 = p.norm2_g + l * D;
    const float* wua = p.w_up_attn + (size_t)l * 512 * D; const float* wup = p.w_up_pool + (size_t)l * 512 * D; const float* wo = p.w_o + (size_t)l * D * D;
    const float* w1 = p.w_mlp_in + (size_t)l * D * FF; const float* w2 = p.w_mlp_out + (size_t)l * FF * D;
    const float* pw = p.pool_w + (size_t)l * 4 * 128 * 128; const float* ps = p.pool_scale + l * 512;
    constexpr int I_PP = 2048, I_IN = 16 * 128, I_UA = 8 * 32, I_O = 16 * 32, I_1 = 16 * 128, I_2 = 64 * 32;
    constexpr int NITEMS = I_PP + I_IN + I_UA + I_O + I_1 + I_2;
    for (int it = gw; it < NITEMS; it += NGW) {
        int r = it;
        if (r < I_PP) {
            const int g = r >> 9, d0 = ((r >> 1) & 255) * 4, cblk = r & 1; const int c = cblk * 64 + lane;
            const float* pwr = pw + (size_t)(g * 128 + c) * 128; const float* psg = ps + g * 128; const float* wu = wup + (size_t)(g * 128) * D + d0;
            f32x4 pwv[32];
#pragma unroll
            for (int jj = 0; jj < 32; ++jj) pwv[jj] = *(const f32x4*)(pwr + 4 * jj);
#pragma unroll
            for (int i = 0; i < 8; ++i) { const int idx = i * 64 + lane; scr[idx] = wu[(size_t)(idx >> 2) * D + (idx & 3)]; }
            asm volatile("s_waitcnt lgkmcnt(0)" ::: "memory");
            f32x4 acc = {0.f, 0.f, 0.f, 0.f};
#pragma unroll
            for (int jj = 0; jj < 32; ++jj) { const f32x4 a4 = pwv[jj] * *(const f32x4*)(psg + 4 * jj);
#pragma unroll
                for (int t = 0; t < 4; ++t) acc += *(const LAS f32x4*)(scr + (4 * jj + t) * 4) * a4[t]; }
#pragma unroll
            for (int dd = 0; dd < 4; ++dd) WuaT[(size_t)(d0 + dd) * 1024 + 512 + g * 128 + c] = f2bf(acc[dd]);
            asm volatile("s_waitcnt lgkmcnt(0)" ::: "memory");
            continue;
        }
        r -= I_PP;
        if (r < I_IN) { const int kb = r >> 7, nb = r & 127, n0 = nb * 32; bf16_t* dst;
            if (n0 < 1024) dst = WinT + (size_t)((n0 & ~255) + 128 * ((n0 >> 5) & 1) + 32 * ((n0 >> 6) & 3)) * D;
            else if (n0 < 1536) dst = WvT + (size_t)(n0 - 1024) * D;
            else dst = WinT + (size_t)(n0 - 512) * D;
            transpose_item(w_in, 4096, D, g1, dst, kb * 64, n0, scr, lane); continue; }
        r -= I_IN;
        if (r < I_UA) { const int kb = r >> 5, nb = r & 31; transpose_item(wua, D, 1024, nullptr, WuaT + (size_t)(nb * 32) * 1024, kb * 64, nb * 32, scr, lane); continue; }
        r -= I_UA;
        if (r < I_O) { const int kb = r >> 5, nb = r & 31; transpose_item(wo, D, D, nullptr, WoT + (size_t)(nb * 32) * D, kb * 64, nb * 32, scr, lane); continue; }
        r -= I_O;
        if (r < I_1) { const int kb = r >> 7, nb = r & 127; transpose_item(w1, FF, D, g2, W1T + (size_t)(nb * 32) * D, kb * 64, nb * 32, scr, lane); continue; }
        r -= I_1;
        { const int kb = r >> 5, nb = r & 31; transpose_item(w2, D, FF, nullptr, W2T + (size_t)(nb * 32) * FF, kb * 64, nb * 32, scr, lane); }
    }
    if (l == 0) {
        bf16_t* xb = (bf16_t*)(ws + WS_XB); float* ssq = (float*)(ws + WS_SSQ);
        for (int m = gw; m < S; m += NGW) {
            const f32x4* xr = (const f32x4*)(p.x + (size_t)m * D) + lane; u32x2* o8 = (u32x2*)(xb + (size_t)m * D) + lane; float s = 0.f;
#pragma unroll
            for (int j = 0; j < 4; ++j) { const f32x4 v = xr[64 * j]; s += (v[0] * v[0] + v[1] * v[1]) + (v[2] * v[2] + v[3] * v[3]); u32x2 w; w.x = pk2(v[0], v[1]); w.y = pk2(v[2], v[3]); o8[64 * j] = w; }
            s = wave_sum(s);
            if (lane < 16) ssq[(size_t)m * 16 + lane] = lane == 0 ? s : 0.f;
        }
    }
}

template <int W> __device__ __forceinline__ void pool_tile(const bf16_t* xp, bf16_t* pooled, int t0, int ch0) {
    u32x4 prev[W], cur[8];
#pragma unroll
    for (int k = 0; k < W; ++k) { const int t = t0 - W + k; prev[k] = t >= 0 ? *(const u32x4*)(xp + (size_t)t * 512 + ch0) : (u32x4){0u, 0u, 0u, 0u}; }
#pragma unroll
    for (int i = 0; i < 8; ++i) cur[i] = *(const u32x4*)(xp + (size_t)(t0 + i) * 512 + ch0);
    float s[8];
#pragma unroll
    for (int c = 0; c < 8; ++c) s[c] = 0.f;
#pragma unroll
    for (int k = 0; k < W; ++k)
#pragma unroll
        for (int c = 0; c < 4; ++c) { s[2 * c] += __uint_as_float(prev[k][c] << 16); s[2 * c + 1] += __uint_as_float(prev[k][c] & 0xffff0000u); }
#pragma unroll
    for (int i = 0; i < 8; ++i) {
        const u32x4 old = i < W ? prev[i < W ? i : 0] : cur[i >= W ? i - W : 0];
        const int t = t0 + i; const float cnt = (float)(t + 1 < W ? t + 1 : W);
        u32x4 o;
#pragma unroll
        for (int c = 0; c < 4; ++c) {
            const float c0 = __uint_as_float(cur[i][c] << 16), c1 = __uint_as_float(cur[i][c] & 0xffff0000u);
            s[2 * c] += c0 - __uint_as_float(old[c] << 16); s[2 * c + 1] += c1 - __uint_as_float(old[c] & 0xffff0000u);
            o[c] = pk2(s[2 * c] / cnt - c0, s[2 * c + 1] / cnt - c1);
        }
        *(u32x4*)(pooled + (size_t)t * 1024 + 512 + ch0) = o;
    }
}
__device__ __forceinline__ void pool_phase(const bf16_t* xp, bf16_t* pooled) {
    int tid_ = threadIdx.x; asm volatile("" : "+v"(tid_));
    const int lane = tid_ & 63, wave = __builtin_amdgcn_readfirstlane(tid_ >> 6);
    const int g = wave & 3, ch0 = g * 128 + (lane & 15) * 8, tsub = (wave >> 2) * 32 + (lane >> 4) * 8;
    for (int chunk = blockIdx.x; chunk < S / 64; chunk += gridDim.x) {
        const int t0 = chunk * 64 + tsub;
        if (g == 0) pool_tile<2>(xp, pooled, t0, ch0); else if (g == 1) pool_tile<4>(xp, pooled, t0, ch0); else if (g == 2) pool_tile<8>(xp, pooled, t0, ch0); else pool_tile<16>(xp, pooled, t0, ch0);
    }
}

constexpr int AT_ROWB = 144, AT_K2 = 64 * AT_ROWB, AT_KST = 2 * AT_K2  , AT_VST = 128 * AT_ROWB  , AT_VOFF = 2 * AT_KST;
#define MFMA32(a, b, c) __builtin_amdgcn_mfma_f32_32x32x16_bf16((a), (b), (c), 0, 0, 0)

__device__ __forceinline__ float at_max3(float a, float b, float c) { float r; asm("v_max3_f32 %0, %1, %2, %3" : "=v"(r) : "v"(a), "v"(b), "v"(c)); return r; }
__device__ __forceinline__ void at_qk_half(const bool ONLINE, const LAS unsigned char* kp, const bf16x8 (&qf)[4], int q, int q0, int kbase, int hh, float& mrun, f32x16 (&O)[4], f32x16& L, bf16x8 (&pf)[4]) {
    __builtin_amdgcn_s_setprio(3);
    bf16x8 kf[8];
#pragma unroll
    for (int s = 0; s < 4; ++s) { kf[2 * s] = *(const LAS bf16x8*)(kp + 32 * s); kf[2 * s + 1] = *(const LAS bf16x8*)(kp + 32 * AT_ROWB + 32 * s); }
    __builtin_amdgcn_sched_barrier(0);
    f32x16 s0, s1;
#pragma unroll
    for (int i = 0; i < 16; ++i) { s0[i] = 0.f; s1[i] = 0.f; }
#pragma unroll
    for (int s = 0; s < 4; ++s) { s0 = MFMA32(kf[2 * s], qf[s], s0); s1 = MFMA32(kf[2 * s + 1], qf[s], s1); }
    __builtin_amdgcn_s_setprio(0);
    if (kbase + 63 > q0) {
        const int kb = kbase + 4 * hh;
#pragma unroll
        for (int i = 0; i < 16; ++i) { const int kv = kb + (i & 3) + 8 * (i >> 2); if (kv > q) s0[i] = -INFINITY; if (kv + 32 > q) s1[i] = -INFINITY; }
    }
    if (ONLINE) {
#pragma unroll
        for (int i = 0; i < 16; ++i) { s0[i] -= mrun; s1[i] -= mrun; }
        float mx = fmaxf(s0[0], s1[0]);
#pragma unroll
        for (int i = 1; i < 16; ++i) mx = at_max3(mx, s0[i], s1[i]);
        mx = half_swap_max(mx);
        if (__builtin_amdgcn_ballot_w64(mx > 8.f) != 0ull) {
            const float d = fmaxf(mx, 0.f); const float alpha = __builtin_amdgcn_exp2f(-d); mrun += d;
#pragma unroll
            for (int e = 0; e < 4; ++e)
#pragma unroll
                for (int i = 0; i < 16; ++i) O[e][i] *= alpha;
#pragma unroll
            for (int i = 0; i < 16; ++i) { L[i] *= alpha; s0[i] -= d; s1[i] -= d; }
        }
    }
#pragma unroll
    for (int i = 0; i < 16; ++i) { s0[i] = __builtin_amdgcn_exp2f(s0[i]); s1[i] = __builtin_amdgcn_exp2f(s1[i]); }
#pragma unroll
    for (int s2 = 0; s2 < 2; ++s2) {
        u32x4 a, b;
        a.x = pk2(s0[8 * s2 + 0], s0[8 * s2 + 1]); a.y = pk2(s0[8 * s2 + 2], s0[8 * s2 + 3]); a.z = pk2(s0[8 * s2 + 4], s0[8 * s2 + 5]); a.w = pk2(s0[8 * s2 + 6], s0[8 * s2 + 7]);
        b.x = pk2(s1[8 * s2 + 0], s1[8 * s2 + 1]); b.y = pk2(s1[8 * s2 + 2], s1[8 * s2 + 3]); b.z = pk2(s1[8 * s2 + 4], s1[8 * s2 + 5]); b.w = pk2(s1[8 * s2 + 6], s1[8 * s2 + 7]);
        pf[s2] = __builtin_bit_cast(bf16x8, a); pf[2 + s2] = __builtin_bit_cast(bf16x8, b);
    }
    __builtin_amdgcn_s_setprio(0);
}
__device__ __forceinline__ void at_pv_half(const LAS unsigned char* vp, const bf16x8 (&pf)[4], f32x16 (&O)[4], f32x16& L) {
    bf16x8 va[8], vb[8];
#pragma unroll
    for (int e = 0; e < 2; ++e)
#pragma unroll
        for (int ks = 0; ks < 4; ++ks) va[e * 4 + ks] = *(const LAS bf16x8*)(vp + e * 32 * AT_ROWB + 32 * ks);
#pragma unroll
    for (int e = 0; e < 2; ++e)
#pragma unroll
        for (int ks = 0; ks < 4; ++ks) vb[e * 4 + ks] = *(const LAS bf16x8*)(vp + (2 + e) * 32 * AT_ROWB + 32 * ks);
    const short one = (short)0x3F80; const bf16x8 ones = {one, one, one, one, one, one, one, one};
    __builtin_amdgcn_sched_barrier(0);
    __builtin_amdgcn_s_setprio(1);
#pragma unroll
    for (int ks = 0; ks < 4; ++ks) L = MFMA32(ones, pf[ks], L);
    __builtin_amdgcn_sched_barrier(0);
#pragma unroll
    for (int ks = 0; ks < 4; ++ks) { O[0] = MFMA32(va[ks], pf[ks], O[0]); O[1] = MFMA32(va[4 + ks], pf[ks], O[1]); }
#pragma unroll
    for (int ks = 0; ks < 4; ++ks) { O[2] = MFMA32(vb[ks], pf[ks], O[2]); O[3] = MFMA32(vb[4 + ks], pf[ks], O[3]); }
    __builtin_amdgcn_s_setprio(0);
}

__device__ __forceinline__ void attn_item(LAS unsigned char* lds, const bf16_t* Q, const bf16_t* Kb, const bf16_t* VT, bf16_t* aout, const float* subg, float lam, float omli, float kbound, int head, int qb) {
    int tid_ = threadIdx.x; asm volatile("" : "+v"(tid_));
    const int tid = tid_, lane = tid & 63, r = lane & 31, hh = lane >> 5; const int wid = __builtin_amdgcn_readfirstlane(tid >> 6);
    const int comp = wid >> 2, qt = wid & 3; const int q0 = qb * 128 + qt * 32, q = q0 + r; const int nt = 2 * qb + 2;
    bf16x8 qf[4];
    { const bf16_t* Qp = Q + ((size_t)(head * 2 + comp) * S + q) * 64 + 8 * hh;
#pragma unroll
      for (int s = 0; s < 4; ++s) qf[s] = *(const bf16x8*)(Qp + 16 * s); }
    const int srow = tid >> 3, sch = tid & 7;
    const char* bK1 = (const char*)(Kb + (size_t)(head * 2 + 0) * S * 64); const char* bK2 = (const char*)(Kb + (size_t)(head * 2 + 1) * S * 64);
    const char* bV0 = (const char*)(VT + (size_t)head * 256 * 128 * 64); const char* bV1 = bV0 + 8192;
    const unsigned koff = srow * 128 + sch * 16, voff = koff;
    const unsigned dK1 = srow * AT_ROWB + sch * 16, dK2 = AT_K2 + dK1, dV0 = AT_VOFF + dK1, dV1 = AT_VOFF + 64 * AT_ROWB + dK1;
    u32x4 ks0 = *(const u32x4*)(bK1 + koff), ks1 = *(const u32x4*)(bK2 + koff), vs0 = *(const u32x4*)(bV0 + voff), vs1 = *(const u32x4*)(bV1 + voff);
    *(LAS u32x4*)(lds + dK1) = ks0; *(LAS u32x4*)(lds + dK2) = ks1; *(LAS u32x4*)(lds + dV0) = vs0; *(LAS u32x4*)(lds + dV1) = vs1;
    ks0 = *(const u32x4*)(bK1 + 8192 + koff); ks1 = *(const u32x4*)(bK2 + 8192 + koff);
    asm volatile("" : "+v"(qf[0]), "+v"(qf[1]), "+v"(qf[2]), "+v"(qf[3]));
    __syncthreads();
    f32x16 O[4];
#pragma unroll
    for (int e = 0; e < 4; ++e)
#pragma unroll
        for (int i = 0; i < 16; ++i) O[e][i] = 0.f;
    float qn2 = 0.f;
#pragma unroll
    for (int s = 0; s < 4; ++s)
#pragma unroll
        for (int e = 0; e < 8; ++e) { const float v = bf2f((bf16_t)qf[s][e]); qn2 += v * v; }
    const float sbound = __builtin_sqrtf(half_swap_sum(qn2)) * kbound;
    const bool online = __builtin_amdgcn_ballot_w64(!(sbound <= 100.f)) != 0ull;
    float mrun = 0.f;
    f32x16 L;
#pragma unroll
    for (int i = 0; i < 16; ++i) L[i] = 0.f;
    bf16x8 pf[4];
#pragma unroll
    for (int i = 0; i < 4; ++i) pf[i] = (bf16x8){0, 0, 0, 0, 0, 0, 0, 0};
    const unsigned kfo = comp * AT_K2 + r * AT_ROWB + 16 * hh, vfo = AT_VOFF + r * AT_ROWB + 16 * hh;
    const int qmax = q0 + 31, ntm1 = nt - 1;
#define AT_ISSUE_V(jn) do { const int jc_ = (jn) < ntm1 ? (jn) : ntm1; const size_t vo_ = (size_t)jc_ * 16384; vs0 = *(const u32x4*)(bV0 + vo_ + voff); vs1 = *(const u32x4*)(bV1 + vo_ + voff); } while (0)
#define AT_ISSUE_K(jn) do { const int jc_ = (jn) < ntm1 ? (jn) : ntm1; const size_t ko_ = (size_t)jc_ * 8192; ks0 = *(const u32x4*)(bK1 + ko_ + koff); ks1 = *(const u32x4*)(bK2 + ko_ + koff); } while (0)
#define AT_WRITE_K(jn) do { LAS unsigned char* n_ = lds + ((jn) & 1) * AT_KST; *(LAS u32x4*)(n_ + dK1) = ks0; *(LAS u32x4*)(n_ + dK2) = ks1; } while (0)
#define AT_WRITE_V(jn) do { LAS unsigned char* n_ = lds + ((jn) & 1) * AT_KST; *(LAS u32x4*)(n_ + dV0) = vs0; *(LAS u32x4*)(n_ + dV1) = vs1; } while (0)
    if (comp == 0) {
        for (int j = 0; j < nt; ++j) {
            const LAS unsigned char* stg = lds + (j & 1) * AT_KST; const int kbase = j * 64; const bool act = kbase <= qmax;
            __builtin_amdgcn_s_setprio(3);
            AT_ISSUE_V(j + 1);
            if (act) at_qk_half(online, stg + kfo, qf, q, q0, kbase, hh, mrun, O, L, pf);
            __builtin_amdgcn_s_setprio(3);
            AT_WRITE_K(j + 1);
            __syncthreads();
            __builtin_amdgcn_s_setprio(0);
            AT_ISSUE_K(j + 2);
            if (act) at_pv_half(stg + vfo, pf, O, L);
            AT_WRITE_V(j + 1);
            __syncthreads();
        }
        __syncthreads();
    } else {
        for (int j = 0; j < nt; ++j) {
            const LAS unsigned char* stg = lds + (j & 1) * AT_KST; const LAS unsigned char* pst = lds + ((j + 1) & 1) * AT_KST; const int kbase = j * 64;
            AT_ISSUE_V(j + 1);
            if (j > 0 && kbase - 64 <= qmax) at_pv_half(pst + vfo, pf, O, L);
            AT_WRITE_K(j + 1);
            __syncthreads();
            __builtin_amdgcn_s_setprio(3);
            AT_ISSUE_K(j + 2);
            if (kbase <= qmax) at_qk_half(online, stg + kfo, qf, q, q0, kbase, hh, mrun, O, L, pf);
            __builtin_amdgcn_s_setprio(3);
            AT_WRITE_V(j + 1);
            __syncthreads();
            __builtin_amdgcn_s_setprio(0);
        }
        if ((nt - 1) * 64 <= qmax) at_pv_half(lds + ((nt - 1) & 1) * AT_KST + vfo, pf, O, L);
        __syncthreads();
    }
#undef AT_ISSUE_V
#undef AT_ISSUE_K
#undef AT_WRITE_K
#undef AT_WRITE_V
    const float inv = 1.f / L[0];
    LAS float* X = (LAS float*)lds;
    if (comp == 1) {
#pragma unroll
        for (int e = 0; e < 4; ++e)
#pragma unroll
            for (int i = 0; i < 16; ++i) X[(qt * 128 + 32 * e + (i & 3) + 8 * (i >> 2) + 4 * hh) * 32 + r] = O[e][i] * inv;
    }
    __syncthreads();
    if (comp == 0) {
        float ss = 0.f;
#pragma unroll
        for (int e = 0; e < 4; ++e)
#pragma unroll
            for (int i = 0; i < 16; ++i) { const float o = O[e][i] * inv - lam * X[(qt * 128 + 32 * e + (i & 3) + 8 * (i >> 2) + 4 * hh) * 32 + r]; O[e][i] = o; ss += o * o; }
        ss = half_swap_sum(ss);
        const float rn = __builtin_amdgcn_rsqf(ss * (1.f / 128.f) + EPS) * omli;
        bf16_t* ap = aout + (size_t)q * 1024 + head * 128 + 4 * hh;
#pragma unroll
        for (int e = 0; e < 4; ++e)
#pragma unroll
            for (int g4 = 0; g4 < 4; ++g4) { const int e0 = 32 * e + 8 * g4; const f32x4 sg = *(const f32x4*)(subg + e0 + 4 * hh);
                u32x2 w; w.x = pk2(O[e][4 * g4 + 0] * rn * sg[0], O[e][4 * g4 + 1] * rn * sg[1]); w.y = pk2(O[e][4 * g4 + 2] * rn * sg[2], O[e][4 * g4 + 3] * rn * sg[3]);
                *(u32x2*)(ap + e0) = w; }
    }
    __syncthreads();
}

__device__ __forceinline__ void attn_phase(LAS unsigned char* lds, const bf16_t* Q, const bf16_t* Kb, const bf16_t* VT, bf16_t* aout, const float* subg, const float* lp, const float* kgain, float lam_init) {
    int tid_ = threadIdx.x; asm volatile("" : "+v"(tid_));
    const int lane = tid_ & 63;
    const float d01 = wave_sum(lp[lane] * lp[64 + lane]), d23 = wave_sum(lp[128 + lane] * lp[192 + lane]);
    const float lam = __expf(d01) - __expf(d23) + lam_init, omli = 1.f - lam_init;
    float kg = fabsf(kgain[lane]);
#pragma unroll
    for (int o = 1; o < 64; o <<= 1) kg = fmaxf(kg, __shfl_xor(kg, o));
    const float kbound = 8.f * kg * 1.0079f;
    for (int it = blockIdx.x; it < 256; it += gridDim.x) {
        const int head = (it & 7) >> 1, pi = ((it >> 3) << 1) | (it & 1);
        attn_item(lds, Q, Kb, VT, aout, subg, lam, omli, kbound, head, 127 - pi);
        attn_item(lds, Q, Kb, VT, aout, subg, lam, omli, kbound, head, pi);
    }
}


#define XB_TMO      128
#define XB_XCNT(j)  (256  + 64 * (j))
#define XB_XSUB(j)  (1280 + 64 * (j))
#define XB_XGEN(j)  (2304 + 64 * (j))
#define XB_TOP      3328
#define XB_TOPGEN   3392
#define XCD_BAR_WORDS 3456
#define XB_SPIN_CAP (1u << 18)
__device__ __forceinline__ unsigned xb_ld(unsigned* p)              { return __hip_atomic_load(p, __ATOMIC_RELAXED, __HIP_MEMORY_SCOPE_AGENT); }
__device__ __forceinline__ unsigned xb_add(unsigned* p, unsigned v) { return __hip_atomic_fetch_add(p, v, __ATOMIC_RELAXED, __HIP_MEMORY_SCOPE_AGENT); }
__device__ __forceinline__ unsigned xb_xcc_id() { return (unsigned)__builtin_amdgcn_s_getreg((3 << 11) | 20) & 0xFu; }
#define XB_SPIN(cond, bar) do { unsigned _sp = 0; while (cond) { __builtin_amdgcn_s_sleep(1); \
    if ((++_sp & 255u) == 0u) { if (xb_ld(&(bar)[XB_TMO])) break; if (_sp > XB_SPIN_CAP) { atomicAdd(&(bar)[XB_TMO], 1u); break; } } } } while (0)
struct XcdBarrier { unsigned* bar; unsigned x; volatile LAS unsigned* st; };
__device__ __forceinline__ XcdBarrier xcd_barrier_post(unsigned* bar, volatile LAS unsigned* st) {
    XcdBarrier b; b.bar = bar; b.x = xb_xcc_id(); b.st = st;
    if (threadIdx.x == 0) (void)xb_add(&bar[XB_XCNT(b.x)], 1u);
    return b;
}
__device__ __forceinline__ void xcd_barrier_complete(unsigned* bar, unsigned x, unsigned& nloc, unsigned& nx) {
    const unsigned G = gridDim.x * gridDim.y * gridDim.z;
    unsigned sum, cnt, mine, sp = 0u;
    for (;;) {
        sum = 0u; cnt = 0u; mine = 0u;
#pragma unroll
        for (unsigned j = 0; j < 16; ++j) { const unsigned c = xb_ld(&bar[XB_XCNT(j)]); sum += c; cnt += (c > 0u) ? 1u : 0u; mine = (j == x) ? c : mine; }
        if (sum == G) break;
        __builtin_amdgcn_s_sleep(1);
        if ((++sp & 255u) == 0u) { if (xb_ld(&bar[XB_TMO])) break; if (sp > XB_SPIN_CAP) { atomicAdd(&bar[XB_TMO], 1u); break; } }
    }
    nloc = mine > 0u ? mine : 1u; nx = cnt > 0u ? cnt : 1u;
}
__device__ __forceinline__ void xcd_barrier(const XcdBarrier& b) {
    asm volatile("s_waitcnt vmcnt(0)" ::: "memory");
    __syncthreads();
    if (threadIdx.x == 0) {
        unsigned* bar = b.bar;
        __builtin_amdgcn_s_waitcnt(0);
        unsigned nloc = b.st[0], nx = b.st[1];
        if (nloc == 0u) { xcd_barrier_complete(bar, b.x, nloc, nx); b.st[0] = nloc; b.st[1] = nx; }
        const unsigned old = xb_add(&bar[XB_XSUB(b.x)], 1u);
        const unsigned gen = old / nloc;
        if (old + 1u == (gen + 1u) * nloc) {
            __builtin_amdgcn_fence(__ATOMIC_RELEASE, "agent");
            asm volatile("s_waitcnt vmcnt(0)" ::: "memory");
            const unsigned og = xb_add(&bar[XB_TOP], 1u);
            const unsigned tg = og / nx;
            if (og + 1u == (tg + 1u) * nx) xb_add(&bar[XB_TOPGEN], 1u);
            else XB_SPIN(xb_ld(&bar[XB_TOPGEN]) == tg, bar);
            __builtin_amdgcn_fence(__ATOMIC_ACQUIRE, "agent");
            xb_add(&bar[XB_XGEN(b.x)], 1u);
            asm volatile("s_waitcnt vmcnt(0)" ::: "memory");
        } else {
            XB_SPIN(xb_ld(&bar[XB_XGEN(b.x)]) == gen, bar);
            __builtin_amdgcn_fence(__ATOMIC_ACQUIRE, "agent");
            asm volatile("s_waitcnt vmcnt(0)" ::: "memory");
        }
    }
    __syncthreads();
}

__global__ void __launch_bounds__(512, 2) mk_fwd(Params p) {
    extern __shared__ __attribute__((aligned(16))) unsigned char lds_raw[];
    LAS unsigned char* lds = (LAS unsigned char*)lds_raw;
    cg::grid_group grid = cg::this_grid();
#define FRESH() int G = gridDim.x, bid = blockIdx.x; size_t wz_ = 0; asm volatile("" : "+s"(G), "+s"(bid), "+s"(wz_)); unsigned char* ws = p.ws + wz_
    XcdBarrier gbar;
    { FRESH(); (void)G;
      unsigned* barw = (unsigned*)(ws + WS_BAR);
      volatile LAS unsigned* bst = (volatile LAS unsigned*)(lds + 131072);
      if (threadIdx.x < 2) bst[threadIdx.x] = 0u;
      if (bid == 0) for (int i = threadIdx.x; i < XCD_BAR_WORDS; i += 512) barw[i] = 0u;
      gbar.bar = barw; gbar.x = 0; gbar.st = bst; }
#pragma unroll 1
    for (int l = 0; l < DEPTH; ++l) {
        const float lam_init = 0.8f - 0.6f * __expf(-0.3f * (float)l);
        prep_phase(p, l, lds);
        if (l == 0) { grid.sync(); gbar = xcd_barrier_post(gbar.bar, gbar.st); }
        else xcd_barrier(gbar);
        {
            FRESH(); float* ssq = (float*)(ws + WS_SSQ); bf16_t* xb = (bf16_t*)(ws + WS_XB);
            pg8::Gemm g{xb, (bf16_t*)(ws + WS_WIN), S, NIN, D}; pg8::StaticOrder So; So.init(S, NIN, G, bid);
            EpiInProj E{ssq, (bf16_t*)(ws + WS_Q), (bf16_t*)(ws + WS_K), (bf16_t*)(ws + WS_XP), (bf16_t*)(ws + WS_GATES), p.q_norm_g + l * 64, p.k_norm_g + l * 64, p.b_gate + l * 2048};
            pg8::gemm_phase<EpiInProj, pg8::StaticOrder, true, true>(lds, g, So, E);
            pg8::Gemm g2{(bf16_t*)(ws + WS_WV), xb, 512, S, D}; pg8::StaticOrder So2; So2.init(512, S, G, (bid + G / 2) % G);
            EpiVT E2{ssq, (bf16_t*)(ws + WS_VT)};
            pg8::gemm_phase<EpiVT, pg8::StaticOrder, true, true>(lds, g2, So2, E2);
        }
        xcd_barrier(gbar);
        {
            FRESH(); (void)G; (void)bid;
            pool_phase((const bf16_t*)(ws + WS_XP), (bf16_t*)(ws + WS_A));
            attn_phase(lds, (const bf16_t*)(ws + WS_Q), (const bf16_t*)(ws + WS_K), (const bf16_t*)(ws + WS_VT), (bf16_t*)(ws + WS_A), p.subln_g + l * 128, p.lam_params + l * 256, p.k_norm_g + l * 64, lam_init);
        }
        xcd_barrier(gbar);
        {
            FRESH(); pg8::StaticOrder So; So.init(S, D, G, bid);
            pg8::Gemm g{(bf16_t*)(ws + WS_A), (bf16_t*)(ws + WS_WUA), S, D, D}; EpiUp E{(const bf16_t*)(ws + WS_GATES), (bf16_t*)(ws + WS_MERGED)};
            pg8::gemm_phase<EpiUp, pg8::StaticOrder, true, true>(lds, g, So, E);
        }
        xcd_barrier(gbar);
        {
            FRESH(); pg8::StaticOrder So; So.init(S, D, G, bid);
            pg8::Gemm g{(bf16_t*)(ws + WS_MERGED), (bf16_t*)(ws + WS_WO), S, D, D};
            if (l == 0) { EpiResid<true, false> E{p.x, nullptr, (bf16_t*)(ws + WS_XB), (float*)(ws + WS_SSQ)}; pg8::gemm_phase<EpiResid<true, false>, pg8::StaticOrder, true, true>(lds, g, So, E); }
            else        { EpiResid<false, false> E{nullptr, nullptr, (bf16_t*)(ws + WS_XB), (float*)(ws + WS_SSQ)}; pg8::gemm_phase<EpiResid<false, false>, pg8::StaticOrder, true, true>(lds, g, So, E); }
        }
        xcd_barrier(gbar);
        {
            FRESH(); pg8::StaticOrder So; So.init(S, FF, G, bid);
            pg8::Gemm g{(bf16_t*)(ws + WS_XB), (bf16_t*)(ws + WS_W1), S, FF, D}; EpiMlpIn E{(float*)(ws + WS_SSQ), (bf16_t*)(ws + WS_U)};
            pg8::gemm_phase<EpiMlpIn, pg8::StaticOrder, true, true>(lds, g, So, E);
        }
        xcd_barrier(gbar);
        {
            FRESH(); pg8::StaticOrder So; So.init(S, D, G, bid);
            pg8::Gemm g{(bf16_t*)(ws + WS_U), (bf16_t*)(ws + WS_W2), S, D, FF};
            if (l + 1 < DEPTH) { EpiResid<false, false> E{nullptr, nullptr, (bf16_t*)(ws + WS_XB), (float*)(ws + WS_SSQ)}; pg8::gemm_phase<EpiResid<false, false>, pg8::StaticOrder, true, true>(lds, g, So, E); }
            else               { EpiResid<false, true> E{nullptr, p.out, (bf16_t*)(ws + WS_XB), nullptr}; pg8::gemm_phase<EpiResid<false, true>, pg8::StaticOrder, true, true>(lds, g, So, E); }
        }
        if (l + 1 < DEPTH) xcd_barrier(gbar);
    }
#undef FRESH
}

extern "C" void kernel_launch(void* const* d_in, const int* in_sizes, int n_in, void* d_out, int out_size, void* d_ws, size_t ws_size, hipStream_t stream) {
    static int grid_blocks = 0;
    if (grid_blocks == 0) {
        if (n_in != 16 || out_size != S * D || ws_size < WS_END) { fprintf(stderr, "kernel_launch: unexpected shapes (n_in %d, out %d, ws %zu)\n", n_in, out_size, ws_size); grid_blocks = -1; return; }
        int dev = 0, cus = 0, per_cu = 0;
        hipGetDevice(&dev); hipDeviceGetAttribute(&cus, hipDeviceAttributeMultiprocessorCount, dev);
        if (hipFuncSetAttribute((const void*)mk_fwd, hipFuncAttributeMaxDynamicSharedMemorySize, LDS_BYTES) != hipSuccess) { fprintf(stderr, "kernel_launch: hipFuncSetAttribute failed\n"); grid_blocks = -1; return; }
        if (hipOccupancyMaxActiveBlocksPerMultiprocessor(&per_cu, (const void*)mk_fwd, 512, LDS_BYTES) != hipSuccess || per_cu < 1) { fprintf(stderr, "kernel_launch: occupancy query says %d blocks per CU\n", per_cu); per_cu = 1; }
        (void)hipGetLastError();
        grid_blocks = cus;
    }
    if (grid_blocks < 0) return;
    Params p{};
    const float** pp = (const float**)&p;
    for (int i = 0; i < 16; ++i) pp[i] = (const float*)d_in[i];
    p.out = (float*)d_out; p.ws = (unsigned char*)d_ws;
    void* args[] = {&p};
    hipError_t e = hipLaunchCooperativeKernel((const void*)mk_fwd, dim3(grid_blocks), dim3(512), args, LDS_BYTES, stream);
    if (e != hipSuccess) fprintf(stderr, "cooperative launch failed: %s (grid %d)\n", hipGetErrorString(e), grid_blocks);
}
```

```cpp
#include <hip/hip_runtime.h>
#include <hip/hip_cooperative_groups.h>
#include <cstdio>
#include <cstdint>
#include <cmath>
namespace cg = cooperative_groups;
namespace pg8 {
#define PG8_LAS __attribute__((address_space(3)))
typedef unsigned short bf16_t;
typedef short bf16x8 __attribute__((ext_vector_type(8)));
typedef float f32x4 __attribute__((ext_vector_type(4)));
typedef unsigned u32x4 __attribute__((ext_vector_type(4)));
constexpr int BM = 256, BK = 64, HALF = 128, HTB = HALF * BK * 2  , STAGE_BYTES = 8 * HTB, NXCD = 8, WGM = 8;

__host__ __device__ __forceinline__ int lds_byte(int r, int c) { const int st = (r >> 4) * 2 + (c >> 5), rr = r & 15, cc = c & 31, ob = rr * 64 + cc * 2; return st * 1024 + (ob ^ (((ob >> 9) & 1) << 5)); }
__host__ __device__ __forceinline__ void stage_rc(int b, int& R, int& C) { const int st = b / 1024, sb = b % 1024, swz = sb ^ (((sb >> 9) & 1) << 5); R = (st >> 1) * 16 + swz / 64; C = (st & 1) * 32 + (swz % 64) / 2; }
__host__ __device__ __forceinline__ int perm32(int rho) { const int n = rho >> 4, i = rho & 15; return 8 * (i >> 2) + 4 * n + (i & 3); }

struct Unit { int pm, pn; };
struct Gemm { const bf16_t* A; const bf16_t* Bt; int M, N, K; };

struct StaticOrder {
    int nM, nN, nwg, G, c;
    __host__ __device__ void init(int M, int N, int G_, int c_) { nM = M / BM; nN = N / BM; nwg = nM * nN; G = G_; c = c_; }
    __host__ __device__ bool next(int i, Unit& u) const {
        const long L = (long)i * G + c; if (L >= nwg) return false;
        int wgid = (int)L; { const int q = nwg / NXCD, r = nwg % NXCD, xcd = wgid % NXCD, off = wgid / NXCD; wgid = (xcd < r ? xcd * (q + 1) : r * (q + 1) + (xcd - r) * q) + off; }
        const int nig = WGM * nN, gid = wgid / nig, fm = gid * WGM, gsz = (nM - fm) < WGM ? (nM - fm) : WGM;
        u.pm = fm + ((wgid % nig) % gsz); u.pn = (wgid % nig) / gsz; return true;
    }
    __device__ __forceinline__ void a_ready(const Unit&) const {}
    __device__ __forceinline__ void done(const Unit&) const {}
};

template <class Epi, class Sched, bool ALIGN_EPI = false, bool SP2 = false>
__device__ __forceinline__ void gemm_phase(PG8_LAS unsigned char* lds, const Gemm g, const Sched& S, const Epi& E) {
    int tid_ = threadIdx.x; asm volatile("" : "+v"(tid_));
    const int tid = tid_, wid = __builtin_amdgcn_readfirstlane(tid >> 6), lane = tid & 63, wr = wid >> 2, wc = wid & 3, fr = lane & 15, fq = lane >> 4;
    const int K = g.K, nt = K / BK;
    unsigned voffA[2], voffB[2];
#pragma unroll
    for (int i = 0; i < 2; ++i) { int R, C; stage_rc(tid * 16 + i * 8192, R, C); const int Rb = Epi::PERM ? ((R & ~31) + perm32(R & 31)) : R;
        voffA[i] = (unsigned)(R * K + C) * 2u; voffB[i] = (unsigned)(Rb * K + C) * 2u; }
    const size_t kstep = (size_t)(BK * 2);
    const size_t hstep = (size_t)HALF * K * 2;
    const size_t tstep = 2 * hstep;
    const unsigned ldsw = (unsigned)wid * 1024u;
    const int aoff = lds_byte(wr * 64 + fr, fq * 8), boff = lds_byte(wc * 32 + fr, fq * 8);
#define PG8_SA(b, h) (((b) * 2 + (h)) * HTB)
#define PG8_SB(b, h) ((4 + (b) * 2 + (h)) * HTB)
#define PG8_STAGE(bufoff, gbase, voff) do { _Pragma("unroll") for (int _i = 0; _i < 2; ++_i) \
        __builtin_amdgcn_global_load_lds((const unsigned*)((const char*)(gbase) + (voff)[_i]), (PG8_LAS unsigned*)(lds + (bufoff) + ldsw + _i * 8192), 16, 0, 0); } while (0)
#define PG8_LDA(dst, b, h) do { _Pragma("unroll") for (int m = 0; m < 4; ++m) _Pragma("unroll") for (int k = 0; k < 2; ++k) dst[m][k] = *(const PG8_LAS bf16x8*)(lds + PG8_SA(b, h) + aoff + m * 2048 + k * 1024); } while (0)
#define PG8_LDB(dst, b, h) do { _Pragma("unroll") for (int n = 0; n < 2; ++n) _Pragma("unroll") for (int k = 0; k < 2; ++k) dst[n][k] = *(const PG8_LAS bf16x8*)(lds + PG8_SB(b, h) + boff + n * 2048 + k * 1024); } while (0)
#define PG8_MMA(ai, bj, At, Bt) do { __builtin_amdgcn_s_setprio(1); _Pragma("unroll") for (int m = 0; m < 4; ++m) _Pragma("unroll") for (int n = 0; n < 2; ++n) _Pragma("unroll") for (int k = 0; k < 2; ++k) \
        acc[ai][bj][m][n] = __builtin_amdgcn_mfma_f32_16x16x32_bf16(Bt[n][k], At[m][k], acc[ai][bj][m][n], 0, 0, 0); __builtin_amdgcn_s_setprio(0); } while (0)
#define PG8_WAIT_V(n) asm volatile("s_waitcnt vmcnt(" #n ")" ::: "memory")
#define PG8_WAIT_L(n) asm volatile("s_waitcnt lgkmcnt(" #n ")" ::: "memory")
#define PG8_BAR __builtin_amdgcn_s_barrier()
#define PG8_SCHED __builtin_amdgcn_sched_barrier(0)
    Unit cur, nxt; int ui = 0;
    if (!S.next(0, cur)) return;
    f32x4 acc[2][2][4][2];
#pragma unroll
    for (int a = 0; a < 2; ++a)
#pragma unroll
        for (int b = 0; b < 2; ++b)
#pragma unroll
            for (int m = 0; m < 4; ++m)
#pragma unroll
                for (int n = 0; n < 2; ++n) acc[a][b][m][n] = (f32x4){0.f, 0.f, 0.f, 0.f};
    bf16x8 At[4][2], B0[2][2], B1[2][2];
    const char* cA = (const char*)g.A + (size_t)cur.pm * tstep; const char* cB = (const char*)g.Bt + (size_t)cur.pn * tstep;
    S.a_ready(cur);
    if constexpr (SP2) {
        PG8_STAGE(PG8_SB(0, 0), cB, voffB); PG8_STAGE(PG8_SB(0, 1), cB + hstep, voffB); PG8_STAGE(PG8_SA(0, 0), cA, voffA); PG8_STAGE(PG8_SA(0, 1), cA + hstep, voffA);
        if (wr == 1) PG8_BAR;
        PG8_WAIT_V(2); PG8_BAR;
        PG8_STAGE(PG8_SB(1, 0), cB + kstep, voffB); PG8_STAGE(PG8_SA(1, 0), cA + kstep, voffA); PG8_STAGE(PG8_SB(1, 1), cB + hstep + kstep, voffB);
        PG8_WAIT_V(6); PG8_BAR;
    } else {
        PG8_STAGE(PG8_SB(0, 0), cB, voffB); PG8_STAGE(PG8_SA(0, 0), cA, voffA); PG8_STAGE(PG8_SB(0, 1), cB + hstep, voffB); PG8_STAGE(PG8_SA(0, 1), cA + hstep, voffA);
        if (wr == 1) PG8_BAR;
        PG8_WAIT_V(4); PG8_BAR;
        PG8_STAGE(PG8_SB(1, 0), cB + kstep, voffB); PG8_STAGE(PG8_SA(1, 0), cA + kstep, voffA); PG8_STAGE(PG8_SB(1, 1), cB + hstep + kstep, voffB);
        PG8_WAIT_V(6); PG8_BAR;
    }
    for (;;) {
        const bool has_next = S.next(ui + 1, nxt);
        const char* nA = has_next ? (const char*)g.A + (size_t)nxt.pm * tstep : cA; const char* nB = has_next ? (const char*)g.Bt + (size_t)nxt.pn * tstep : cB;
        for (int t = 0; t < nt; t += 2) {
            const bool last = (t == nt - 2);
            const char* a1 = cA + (size_t)(t + 1) * kstep;
            const char* a2 = last ? nA : cA + (size_t)(t + 2) * kstep; const char* b2 = last ? nB : cB + (size_t)(t + 2) * kstep;
            const char* a3 = a2 + kstep; const char* b3 = b2 + kstep;
            if (last && has_next) S.a_ready(nxt);
            if constexpr (SP2) {
            PG8_LDB(B0, 0, 0); PG8_LDB(B1, 0, 1); PG8_SCHED; PG8_LDA(At, 0, 0); PG8_STAGE(PG8_SA(1, 1), a1 + hstep, voffA);
            PG8_WAIT_V(8); PG8_WAIT_L(0); PG8_BAR; PG8_MMA(0, 0, At, B0); PG8_MMA(0, 1, At, B1); PG8_BAR; PG8_SCHED;
            PG8_LDA(At, 0, 1); PG8_STAGE(PG8_SB(0, 0), b2, voffB); PG8_STAGE(PG8_SB(0, 1), b2 + hstep, voffB); PG8_STAGE(PG8_SA(0, 0), a2, voffA);
            PG8_WAIT_V(8); PG8_WAIT_L(0); PG8_BAR; PG8_MMA(1, 0, At, B0); PG8_MMA(1, 1, At, B1); PG8_BAR; PG8_SCHED;
            PG8_LDB(B0, 1, 0); PG8_LDB(B1, 1, 1); PG8_SCHED; PG8_LDA(At, 1, 0); PG8_STAGE(PG8_SA(0, 1), a2 + hstep, voffA);
            PG8_WAIT_V(8); PG8_WAIT_L(0); PG8_BAR; PG8_MMA(0, 0, At, B0); PG8_MMA(0, 1, At, B1); PG8_BAR; PG8_SCHED;
            PG8_LDA(At, 1, 1); PG8_STAGE(PG8_SB(1, 0), b3, voffB); PG8_STAGE(PG8_SB(1, 1), b3 + hstep, voffB); PG8_STAGE(PG8_SA(1, 0), a3, voffA);
            PG8_WAIT_V(8); PG8_WAIT_L(0); PG8_BAR; PG8_MMA(1, 0, At, B0); PG8_MMA(1, 1, At, B1); PG8_BAR; PG8_SCHED;
            } else {
            PG8_LDB(B0, 0, 0); PG8_SCHED; PG8_LDA(At, 0, 0); PG8_STAGE(PG8_SA(1, 1), a1 + hstep, voffA);
            PG8_WAIT_L(8); PG8_BAR; PG8_WAIT_L(0); PG8_MMA(0, 0, At, B0); PG8_BAR; PG8_SCHED;
            PG8_LDB(B1, 0, 1); PG8_STAGE(PG8_SB(0, 0), b2, voffB);
            PG8_BAR; PG8_WAIT_L(0); PG8_MMA(0, 1, At, B1); PG8_BAR;
            PG8_LDA(At, 0, 1); PG8_STAGE(PG8_SA(0, 0), a2, voffA);
            PG8_BAR; PG8_WAIT_L(0); PG8_MMA(1, 0, At, B0); PG8_BAR; PG8_SCHED;
            PG8_STAGE(PG8_SB(0, 1), b2 + hstep, voffB);
            PG8_WAIT_V(6); PG8_BAR; PG8_MMA(1, 1, At, B1); PG8_BAR;
            PG8_LDB(B0, 1, 0); PG8_SCHED; PG8_LDA(At, 1, 0); PG8_STAGE(PG8_SA(0, 1), a2 + hstep, voffA);
            PG8_WAIT_L(8); PG8_BAR; PG8_WAIT_L(0); PG8_MMA(0, 0, At, B0); PG8_BAR; PG8_SCHED;
            PG8_LDB(B1, 1, 1); PG8_STAGE(PG8_SB(1, 0), b3, voffB);
            PG8_BAR; PG8_WAIT_L(0); PG8_MMA(0, 1, At, B1); PG8_BAR;
            PG8_LDA(At, 1, 1); PG8_STAGE(PG8_SA(1, 0), a3, voffA);
            PG8_BAR; PG8_WAIT_L(0); PG8_MMA(1, 0, At, B0); PG8_BAR; PG8_SCHED;
            PG8_STAGE(PG8_SB(1, 1), b3 + hstep, voffB);
            PG8_WAIT_V(6); PG8_BAR; PG8_MMA(1, 1, At, B1); PG8_BAR;
            }
            if constexpr (Epi::MID_HOOK) { if (t == Epi::MID_T) E.mid(acc, cur, wr, wc, fr, fq); }
        }
        if constexpr (ALIGN_EPI) { if (wr == 0) PG8_BAR; }
        if constexpr (!Epi::AFTER_DRAIN) { E(acc, cur, wr, wc, fr, fq); S.done(cur); }
        if (!has_next) break;
#pragma unroll
        for (int a = 0; a < 2; ++a)
#pragma unroll
            for (int b = 0; b < 2; ++b)
#pragma unroll
                for (int m = 0; m < 4; ++m)
#pragma unroll
                    for (int n = 0; n < 2; ++n) acc[a][b][m][n] = (f32x4){0.f, 0.f, 0.f, 0.f};
        cur = nxt; cA = nA; cB = nB; ++ui;
        if constexpr (ALIGN_EPI) { if (wr == 1) PG8_BAR; }
    }
    PG8_WAIT_V(0);
    if constexpr (!ALIGN_EPI) { if (wr == 0) PG8_BAR; }
    PG8_BAR;
    if constexpr (Epi::AFTER_DRAIN) { E.fused(acc, cur, wr, wc, fr, fq, lds, wid, lane); S.done(cur); }
#undef PG8_SA
#undef PG8_SB
#undef PG8_STAGE
#undef PG8_LDA
#undef PG8_LDB
#undef PG8_MMA
#undef PG8_WAIT_V
#undef PG8_WAIT_L
#undef PG8_BAR
#undef PG8_SCHED
}
}
#define LAS __attribute__((address_space(3)))
typedef unsigned short bf16_t;
typedef short bf16x8 __attribute__((ext_vector_type(8)));
typedef float f32x4 __attribute__((ext_vector_type(4)));
typedef float f32x2 __attribute__((ext_vector_type(2)));
typedef float f32x16 __attribute__((ext_vector_type(16)));
typedef unsigned u32x4 __attribute__((ext_vector_type(4)));
typedef unsigned u32x2 __attribute__((ext_vector_type(2)));
typedef __bf16 bf16x2_t __attribute__((ext_vector_type(2)));

constexpr int S = 16384, D = 1024, DEPTH = 4, NIN = 3584  , FF = 4096;
constexpr float EPS = 1e-6f;
constexpr float QSCALE = 0.125f * 1.4426950408889634f;
constexpr float LOG2E = 1.4426950408889634f;

__device__ __forceinline__ unsigned pk2(float lo, float hi) { f32x2 v = {lo, hi}; bf16x2_t b = __builtin_convertvector(v, bf16x2_t); return __builtin_bit_cast(unsigned, b); }
__device__ __forceinline__ float bf2f(bf16_t v) { return __uint_as_float(((unsigned)v) << 16); }
__device__ __forceinline__ bf16_t f2bf(float f) { return (bf16_t)(pk2(f, 0.f) & 0xffffu); }
__device__ __forceinline__ float wave_sum(float v) {
#pragma unroll
    for (int o = 1; o < 64; o <<= 1) v += __shfl_xor(v, o);
    return v;
}
__device__ __forceinline__ float half_swap_sum(float v) { auto rr = __builtin_amdgcn_permlane32_swap(__float_as_uint(v), __float_as_uint(v), false, false); return __uint_as_float(rr[0]) + __uint_as_float(rr[1]); }
__device__ __forceinline__ float half_swap_max(float v) { auto rr = __builtin_amdgcn_permlane32_swap(__float_as_uint(v), __float_as_uint(v), false, false); return fmaxf(__uint_as_float(rr[0]), __uint_as_float(rr[1])); }

__device__ __forceinline__ float row_rstd(const float* ssq, int row) {
    const f32x4* p = (const f32x4*)(ssq + (size_t)row * 16);
    const f32x4 a = p[0], b = p[1], c = p[2], d = p[3];
    const f32x4 s = (a + b) + (c + d);
    const float t = (s[0] + s[1]) + (s[2] + s[3]);
    return __builtin_amdgcn_rsqf(t * (1.f / 1024.f) + EPS);
}

using pg8::Unit;
typedef f32x4 acc_t[2][2][4][2];

struct EpiInProj {
    static constexpr bool PERM = true, AFTER_DRAIN = false, MID_HOOK = false; static constexpr int MID_T = -1;
    const float* ssq; bf16_t* Q; bf16_t* Kb; bf16_t* xp; bf16_t* gates; const float* qg; const float* kg; const float* bg;
    __device__ __forceinline__ void operator()(const acc_t& acc, const Unit& u, int wr, int wc, int fr, int fq) const {
        const int row0 = u.pm * 256 + wr * 64 + fr, pn = u.pn;
        if (pn < 4) {
            const bool isq = pn < 2; const float* g = isq ? qg : kg; const float sc = isq ? QSCALE : 1.f;
            bf16_t* base = (isq ? Q : Kb) + (size_t)((pn & 1) * 4 + wc) * S * 64;
            f32x4 gv[2][2];
#pragma unroll
            for (int bj = 0; bj < 2; ++bj)
#pragma unroll
                for (int n = 0; n < 2; ++n) gv[bj][n] = *(const f32x4*)(g + 32 * bj + 8 * fq + 4 * n) * sc;
#pragma unroll
            for (int ai = 0; ai < 2; ++ai)
#pragma unroll
                for (int m = 0; m < 4; ++m) {
                    const int row = row0 + ai * 128 + m * 16; const float rs = row_rstd(ssq, row);
                    f32x4 v[2][2]; float ss = 0.f;
#pragma unroll
                    for (int bj = 0; bj < 2; ++bj)
#pragma unroll
                        for (int n = 0; n < 2; ++n) { v[bj][n] = acc[ai][bj][m][n] * rs; const f32x4 q2 = v[bj][n] * v[bj][n]; ss += (q2[0] + q2[1]) + (q2[2] + q2[3]); }
                    ss += __shfl_xor(ss, 16); ss += __shfl_xor(ss, 32);
                    const float r2 = __builtin_amdgcn_rsqf(ss * (1.f / 64.f) + EPS);
#pragma unroll
                    for (int bj = 0; bj < 2; ++bj) { const f32x4 a = v[bj][0] * r2 * gv[bj][0], b = v[bj][1] * r2 * gv[bj][1];
                        u32x4 w; w.x = pk2(a[0], a[1]); w.y = pk2(a[2], a[3]); w.z = pk2(b[0], b[1]); w.w = pk2(b[2], b[3]);
                        *(u32x4*)(base + (size_t)row * 64 + 32 * bj + 8 * fq) = w; }
                }
        } else if (pn < 6) {
            const int col0 = (pn - 4) * 256 + wc * 32 + 8 * fq;
#pragma unroll
            for (int ai = 0; ai < 2; ++ai)
#pragma unroll
                for (int m = 0; m < 4; ++m) {
                    const int row = row0 + ai * 128 + m * 16; const float rs = row_rstd(ssq, row);
#pragma unroll
                    for (int bj = 0; bj < 2; ++bj) { const f32x4 a = acc[ai][bj][m][0] * rs, b = acc[ai][bj][m][1] * rs;
                        u32x4 w; w.x = pk2(a[0], a[1]); w.y = pk2(a[2], a[3]); w.z = pk2(b[0], b[1]); w.w = pk2(b[2], b[3]);
                        *(u32x4*)(xp + (size_t)row * 512 + col0 + bj * 128) = w; }
                }
        } else {
            const int col0 = (pn - 6) * 256 + wc * 32 + 8 * fq;
            f32x4 bv[2][2];
#pragma unroll
            for (int bj = 0; bj < 2; ++bj)
#pragma unroll
                for (int n = 0; n < 2; ++n) bv[bj][n] = *(const f32x4*)(bg + col0 + bj * 128 + 4 * n) * (-LOG2E);
#pragma unroll
            for (int ai = 0; ai < 2; ++ai)
#pragma unroll
                for (int m = 0; m < 4; ++m) {
                    const int row = row0 + ai * 128 + m * 16; const float rs = row_rstd(ssq, row) * (-LOG2E);
#pragma unroll
                    for (int bj = 0; bj < 2; ++bj) { f32x4 a = acc[ai][bj][m][0] * rs + bv[bj][0], b = acc[ai][bj][m][1] * rs + bv[bj][1];
#pragma unroll
                        for (int j = 0; j < 4; ++j) { a[j] = __builtin_amdgcn_rcpf(1.f + __builtin_amdgcn_exp2f(a[j])); b[j] = __builtin_amdgcn_rcpf(1.f + __builtin_amdgcn_exp2f(b[j])); }
                        u32x4 w; w.x = pk2(a[0], a[1]); w.y = pk2(a[2], a[3]); w.z = pk2(b[0], b[1]); w.w = pk2(b[2], b[3]);
                        *(u32x4*)(gates + (size_t)row * 2048 + col0 + bj * 128) = w; }
                }
        }
    }
};

struct EpiVT {
    static constexpr bool PERM = false, AFTER_DRAIN = false, MID_HOOK = false; static constexpr int MID_T = -1;
    const float* ssq; bf16_t* VT;
    __device__ __forceinline__ void operator()(const acc_t& acc, const Unit& u, int wr, int wc, int fr, int fq) const {
        const int f0 = u.pm * 256 + wr * 64 + fr; const int sfq = ((fq & 1) << 1) | (fq >> 1);
#pragma unroll
        for (int bj = 0; bj < 2; ++bj)
#pragma unroll
            for (int n = 0; n < 2; ++n) {
                const int tg = u.pn * 256 + bj * 128 + wc * 32 + n * 16; const int tok = tg + 4 * fq;
                f32x4 rs; rs[0] = row_rstd(ssq, tok); rs[1] = row_rstd(ssq, tok + 1); rs[2] = row_rstd(ssq, tok + 2); rs[3] = row_rstd(ssq, tok + 3);
#pragma unroll
                for (int ai = 0; ai < 2; ++ai)
#pragma unroll
                    for (int m = 0; m < 4; ++m) { const f32x4 v = acc[ai][bj][m][n] * rs; u32x2 w; w.x = pk2(v[0], v[1]); w.y = pk2(v[2], v[3]);
                        const int f = f0 + ai * 128 + m * 16;
                        *(u32x2*)(VT + ((size_t)((f >> 7) * 256 + (tg >> 6)) * 128 + (f & 127)) * 64 + (tg & 63) + 4 * sfq) = w; }
            }
    }
};

struct EpiUp {
    static constexpr bool PERM = true, AFTER_DRAIN = false, MID_HOOK = true; static constexpr int MID_T = 6;
    const bf16_t* gates; bf16_t* merged;
    static __device__ __forceinline__ void unpack8(const u32x4 w, f32x4& a, f32x4& b) {
        a[0] = __uint_as_float(w.x << 16); a[1] = __uint_as_float(w.x & 0xffff0000u); a[2] = __uint_as_float(w.y << 16); a[3] = __uint_as_float(w.y & 0xffff0000u);
        b[0] = __uint_as_float(w.z << 16); b[1] = __uint_as_float(w.z & 0xffff0000u); b[2] = __uint_as_float(w.w << 16); b[3] = __uint_as_float(w.w & 0xffff0000u);
    }
    __device__ __forceinline__ void mid(acc_t& acc, const Unit& u, int, int, int, int) const {
        int tid = threadIdx.x; asm volatile("" : "+v"(tid));
        const int wid = tid >> 6, lane = tid & 63, wr = wid >> 2, wc = wid & 3, fr = lane & 15, fq = lane >> 4;
        const int row0 = u.pm * 256 + wr * 64 + fr, col0 = u.pn * 256 + wc * 32 + 8 * fq;
#pragma unroll
        for (int ai = 0; ai < 2; ++ai)
#pragma unroll
            for (int m = 0; m < 4; ++m) { const bf16_t* gr = gates + (size_t)(row0 + ai * 128 + m * 16) * 2048 + col0;
#pragma unroll
                for (int bj = 0; bj < 2; ++bj) { f32x4 a0, a1, b0, b1; unpack8(*(const u32x4*)(gr + bj * 128), a0, a1); unpack8(*(const u32x4*)(gr + 1024 + bj * 128), b0, b1);
#pragma unroll
                    for (int j = 0; j < 4; ++j) { a0[j] *= __builtin_amdgcn_rcpf(fmaxf(b0[j], 1e-20f)); a1[j] *= __builtin_amdgcn_rcpf(fmaxf(b1[j], 1e-20f)); }
                    acc[ai][bj][m][0] *= a0; acc[ai][bj][m][1] *= a1; }
                asm volatile("" ::: "memory"); }
    }
    __device__ __forceinline__ void operator()(const acc_t& acc, const Unit& u, int wr, int wc, int fr, int fq) const {
        const int row0 = u.pm * 256 + wr * 64 + fr, col0 = u.pn * 256 + wc * 32 + 8 * fq;
#pragma unroll
        for (int ai = 0; ai < 2; ++ai)
#pragma unroll
            for (int m = 0; m < 4; ++m) { const int row = row0 + ai * 128 + m * 16; const bf16_t* gr = gates + (size_t)row * 2048 + 1024 + col0;
#pragma unroll
                for (int bj = 0; bj < 2; ++bj) { f32x4 b0, b1; unpack8(*(const u32x4*)(gr + bj * 128), b0, b1);
#pragma unroll
                    for (int j = 0; j < 4; ++j) { b0[j] = fmaxf(b0[j], 1e-20f); b1[j] = fmaxf(b1[j], 1e-20f); }
                    const f32x4 a = acc[ai][bj][m][0] * b0, b = acc[ai][bj][m][1] * b1;
                    u32x4 w; w.x = pk2(a[0], a[1]); w.y = pk2(a[2], a[3]); w.z = pk2(b[0], b[1]); w.w = pk2(b[2], b[3]);
                    *(u32x4*)(merged + (size_t)row * 1024 + col0 + bj * 128) = w; } }
    }
};
template <bool IN_F32, bool OUT_F32>
struct EpiResid {
    static constexpr bool PERM = false, AFTER_DRAIN = false, MID_HOOK = false; static constexpr int MID_T = -1;
    const float* xin; float* xout; bf16_t* xb; float* ssq;
    __device__ __forceinline__ void operator()(const acc_t& acc, const Unit& u, int wr, int wc, int fr, int fq) const {
        const int row0 = u.pm * 256 + wr * 64 + fr, col0 = u.pn * 256 + wc * 32 + 4 * fq;
#pragma unroll
        for (int ai = 0; ai < 2; ++ai) {
            f32x4 xv[4][2][2];
#pragma unroll
            for (int m = 0; m < 4; ++m)
#pragma unroll
                for (int bj = 0; bj < 2; ++bj)
#pragma unroll
                    for (int n = 0; n < 2; ++n) { const size_t off = (size_t)(row0 + ai * 128 + m * 16) * 1024 + col0 + bj * 128 + n * 16;
                        if (IN_F32) xv[m][bj][n] = *(const f32x4*)(xin + off);
                        else { const u32x2 h = *(const u32x2*)(xb + off);
                            xv[m][bj][n][0] = __uint_as_float(h.x << 16); xv[m][bj][n][1] = __uint_as_float(h.x & 0xffff0000u); xv[m][bj][n][2] = __uint_as_float(h.y << 16); xv[m][bj][n][3] = __uint_as_float(h.y & 0xffff0000u); } }
#pragma unroll
            for (int m = 0; m < 4; ++m) { const int row = row0 + ai * 128 + m * 16; float ss = 0.f;
#pragma unroll
                for (int bj = 0; bj < 2; ++bj)
#pragma unroll
                    for (int n = 0; n < 2; ++n) { const size_t off = (size_t)row * 1024 + col0 + bj * 128 + n * 16;
                        const f32x4 v = xv[m][bj][n] + acc[ai][bj][m][n];
                        if (OUT_F32) *(f32x4*)(xout + off) = v;
                        else { u32x2 w; w.x = pk2(v[0], v[1]); w.y = pk2(v[2], v[3]); *(u32x2*)(xb + off) = w;
                            const f32x4 q2 = v * v; ss += (q2[0] + q2[1]) + (q2[2] + q2[3]); } }
                if (!OUT_F32) { ss += __shfl_xor(ss, 16); ss += __shfl_xor(ss, 32);
                    if (fq == 0) ssq[(size_t)row * 16 + u.pn * 4 + wc] = ss; } }
        }
    }
};
struct EpiMlpIn {
    static constexpr bool PERM = true, AFTER_DRAIN = false, MID_HOOK = false; static constexpr int MID_T = -1;
    const float* ssq; bf16_t* U;
    __device__ __forceinline__ void operator()(const acc_t& acc, const Unit& u, int wr, int wc, int fr, int fq) const {
        const int row0 = u.pm * 256 + wr * 64 + fr, col0 = u.pn * 256 + wc * 32 + 8 * fq;
#pragma unroll
        for (int ai = 0; ai < 2; ++ai)
#pragma unroll
            for (int m = 0; m < 4; ++m) { const int row = row0 + ai * 128 + m * 16; const float rs = row_rstd(ssq, row);
#pragma unroll
                for (int bj = 0; bj < 2; ++bj) { f32x4 a = acc[ai][bj][m][0] * rs, b = acc[ai][bj][m][1] * rs;
#pragma unroll
                    for (int j = 0; j < 4; ++j) { a[j] = fmaxf(a[j], 0.f); a[j] *= a[j]; b[j] = fmaxf(b[j], 0.f); b[j] *= b[j]; }
                    u32x4 w; w.x = pk2(a[0], a[1]); w.y = pk2(a[2], a[3]); w.z = pk2(b[0], b[1]); w.w = pk2(b[2], b[3]);
                    *(u32x4*)(U + (size_t)row * FF + col0 + bj * 128) = w; } }
    }
};
constexpr size_t MiB = 1u << 20;
constexpr size_t WS_SSQ = 0;
constexpr size_t WS_WIN = 1 * MiB, WS_WV = 8 * MiB, WS_WUA = 9 * MiB, WS_WPP = 10 * MiB, WS_WO = 11 * MiB, WS_W1 = 13 * MiB, WS_W2 = 21 * MiB;
constexpr size_t WS_BAR = 29 * MiB;
constexpr size_t WS_XB = 32 * MiB;
constexpr size_t WS_Q = 64 * MiB, WS_K = 80 * MiB, WS_VT = 96 * MiB, WS_XP = 112 * MiB, WS_GATES = 128 * MiB;
constexpr size_t WS_U = 64 * MiB;
constexpr size_t WS_A = 192 * MiB  , WS_MERGED = 224 * MiB, WS_END = 256 * MiB;
constexpr int LDS_BYTES = 131072 + 1024;

__device__ __forceinline__ void transpose_item(const float* W, int ldw, int Kd, const float* gk, bf16_t* WTrow0, int k0, int n0, LAS float* scr, int lane) {
    float tv[32];
#pragma unroll
    for (int i = 0; i < 32; ++i) tv[i] = W[(size_t)(k0 + 2 * i + (lane >> 5)) * ldw + n0 + (lane & 31)];
    if (gk) {
        float gvv[32];
#pragma unroll
        for (int i = 0; i < 32; ++i) gvv[i] = gk[k0 + 2 * i + (lane >> 5)];
#pragma unroll
        for (int i = 0; i < 32; ++i) tv[i] *= gvv[i];
    }
#pragma unroll
    for (int i = 0; i < 32; ++i) scr[(2 * i + (lane >> 5)) * 33 + (lane & 31)] = tv[i];
    asm volatile("s_waitcnt lgkmcnt(0)" ::: "memory");
    const int c = lane & 7;
#pragma unroll
    for (int j = 0; j < 4; ++j) { const int n = (lane >> 3) + 8 * j; const LAS float* s = scr + (8 * c) * 33 + n;
        u32x4 o; o.x = pk2(s[0 * 33], s[1 * 33]); o.y = pk2(s[2 * 33], s[3 * 33]); o.z = pk2(s[4 * 33], s[5 * 33]); o.w = pk2(s[6 * 33], s[7 * 33]);
        *(u32x4*)(WTrow0 + (size_t)n * Kd + k0 + 8 * c) = o; }
    asm volatile("s_waitcnt lgkmcnt(0)" ::: "memory");
}

struct Params {
    const float *x, *norm1_g, *w_in, *b_gate, *q_norm_g, *k_norm_g, *lam_params, *subln_g, *pool_w, *pool_scale, *w_up_attn, *w_up_pool, *w_o, *norm2_g, *w_mlp_in, *w_mlp_out;
    float* out; unsigned char* ws;
};

__device__ __forceinline__ void prep_phase(const Params& p, int l, LAS unsigned char* lds) {
    int tid_ = threadIdx.x; asm volatile("" : "+v"(tid_));
    const int lane = tid_ & 63, wave = __builtin_amdgcn_readfirstlane(tid_ >> 6);
    LAS float* scr = (LAS float*)(lds + wave * 16384);
    const int gw = blockIdx.x * 8 + wave, NGW = gridDim.x * 8;
    unsigned char* ws = p.ws;
    bf16_t* WinT = (bf16_t*)(ws + WS_WIN); bf16_t* WvT = (bf16_t*)(ws + WS_WV); bf16_t* WuaT = (bf16_t*)(ws + WS_WUA);
    bf16_t* WoT = (bf16_t*)(ws + WS_WO); bf16_t* W1T = (bf16_t*)(ws + WS_W1); bf16_t* W2T = (bf16_t*)(ws + WS_W2);
    const float* w_in = p.w_in + (size_t)l * D * 4096; const float* g1 = p.norm1_g + l * D; const float* g2 = p.norm2_g + l * D;
    const float* wua = p.w_up_attn + (size_t)l * 512 * D; const float* wup = p.w_up_pool + (size_t)l * 512 * D; const float* wo = p.w_o + (size_t)l * D * D;
    const float* w1 = p.w_mlp_in + (size_t)l * D * FF; const float* w2 = p.w_mlp_out + (size_t)l * FF * D;
    const float* pw = p.pool_w + (size_t)l * 4 * 128 * 128; const float* ps = p.pool_scale + l * 512;
    constexpr int I_PP = 2048, I_IN = 16 * 128, I_UA = 8 * 32, I_O = 16 * 32, I_1 = 16 * 128, I_2 = 64 * 32;
    constexpr int NITEMS = I_PP + I_IN + I_UA + I_O + I_1 + I_2;
    for (int it = gw; it < NITEMS; it += NGW) {
        int r = it;
        if (r < I_PP) {
            const int g = r >> 9, d0 = ((r >> 1) & 255) * 4, cblk = r & 1; const int c = cblk * 64 + lane;
            const float* pwr = pw + (size_t)(g * 128 + c) * 128; const float* psg = ps + g * 128; const float* wu = wup + (size_t)(g * 128) * D + d0;
            f32x4 pwv[32];
#pragma unroll
            for (int jj = 0; jj < 32; ++jj) pwv[jj] = *(const f32x4*)(pwr + 4 * jj);
#pragma unroll
            for (int i = 0; i < 8; ++i) { const int idx = i * 64 + lane; scr[idx] = wu[(size_t)(idx >> 2) * D + (idx & 3)]; }
            asm volatile("s_waitcnt lgkmcnt(0)" ::: "memory");
            f32x4 acc = {0.f, 0.f, 0.f, 0.f};
#pragma unroll
            for (int jj = 0; jj < 32; ++jj) { const f32x4 a4 = pwv[jj] * *(const f32x4*)(psg + 4 * jj);
#pragma unroll
                for (int t = 0; t < 4; ++t) acc += *(const LAS f32x4*)(scr + (4 * jj + t) * 4) * a4[t]; }
#pragma unroll
            for (int dd = 0; dd < 4; ++dd) WuaT[(size_t)(d0 + dd) * 1024 + 512 + g * 128 + c] = f2bf(acc[dd]);
            asm volatile("s_waitcnt lgkmcnt(0)" ::: "memory");
            continue;
        }
        r -= I_PP;
        if (r < I_IN) { const int kb = r >> 7, nb = r & 127, n0 = nb * 32; bf16_t* dst;
            if (n0 < 1024) dst = WinT + (size_t)((n0 & ~255) + 128 * ((n0 >> 5) & 1) + 32 * ((n0 >> 6) & 3)) * D;
            else if (n0 < 1536) dst = WvT + (size_t)(n0 - 1024) * D;
            else dst = WinT + (size_t)(n0 - 512) * D;
            transpose_item(w_in, 4096, D, g1, dst, kb * 64, n0, scr, lane); continue; }
        r -= I_IN;
        if (r < I_UA) { const int kb = r >> 5, nb = r & 31; transpose_item(wua, D, 1024, nullptr, WuaT + (size_t)(nb * 32) * 1024, kb * 64, nb * 32, scr, lane); continue; }
        r -= I_UA;
        if (r < I_O) { const int kb = r >> 5, nb = r & 31; transpose_item(wo, D, D, nullptr, WoT + (size_t)(nb * 32) * D, kb * 64, nb * 32, scr, lane); continue; }
        r -= I_O;
        if (r < I_1) { const int kb = r >> 7, nb = r & 127; transpose_item(w1, FF, D, g2, W1T + (size_t)(nb * 32) * D, kb * 64, nb * 32, scr, lane); continue; }
        r -= I_1;
        { const int kb = r >> 5, nb = r & 31; transpose_item(w2, D, FF, nullptr, W2T + (size_t)(nb * 32) * FF, kb * 64, nb * 32, scr, lane); }
    }
    if (l == 0) {
        bf16_t* xb = (bf16_t*)(ws + WS_XB); float* ssq = (float*)(ws + WS_SSQ);
        for (int m = gw; m < S; m += NGW) {
            const f32x4* xr = (const f32x4*)(p.x + (size_t)m * D) + lane; u32x2* o8 = (u32x2*)(xb + (size_t)m * D) + lane; float s = 0.f;
#pragma unroll
            for (int j = 0; j < 4; ++j) { const f32x4 v = xr[64 * j]; s += (v[0] * v[0] + v[1] * v[1]) + (v[2] * v[2] + v[3] * v[3]); u32x2 w; w.x = pk2(v[0], v[1]); w.y = pk2(v[2], v[3]); o8[64 * j] = w; }
            s = wave_sum(s);
            if (lane < 16) ssq[(size_t)m * 16 + lane] = lane == 0 ? s : 0.f;
        }
    }
}

template <int W> __device__ __forceinline__ void pool_tile(const bf16_t* xp, bf16_t* pooled, int t0, int ch0) {
    u32x4 prev[W], cur[8];
#pragma unroll
    for (int k = 0; k < W; ++k) { const int t = t0 - W + k; prev[k] = t >= 0 ? *(const u32x4*)(xp + (size_t)t * 512 + ch0) : (u32x4){0u, 0u, 0u, 0u}; }
#pragma unroll
    for (int i = 0; i < 8; ++i) cur[i] = *(const u32x4*)(xp + (size_t)(t0 + i) * 512 + ch0);
    float s[8];
#pragma unroll
    for (int c = 0; c < 8; ++c) s[c] = 0.f;
#pragma unroll
    for (int k = 0; k < W; ++k)
#pragma unroll
        for (int c = 0; c < 4; ++c) { s[2 * c] += __uint_as_float(prev[k][c] << 16); s[2 * c + 1] += __uint_as_float(prev[k][c] & 0xffff0000u); }
#pragma unroll
    for (int i = 0; i < 8; ++i) {
        const u32x4 old = i < W ? prev[i < W ? i : 0] : cur[i >= W ? i - W : 0];
        const int t = t0 + i; const float cnt = (float)(t + 1 < W ? t + 1 : W);
        u32x4 o;
#pragma unroll
        for (int c = 0; c < 4; ++c) {
            const float c0 = __uint_as_float(cur[i][c] << 16), c1 = __uint_as_float(cur[i][c] & 0xffff0000u);
            s[2 * c] += c0 - __uint_as_float(old[c] << 16); s[2 * c + 1] += c1 - __uint_as_float(old[c] & 0xffff0000u);
            o[c] = pk2(s[2 * c] / cnt - c0, s[2 * c + 1] / cnt - c1);
        }
        *(u32x4*)(pooled + (size_t)t * 1024 + 512 + ch0) = o;
    }
}
__device__ __forceinline__ void pool_phase(const bf16_t* xp, bf16_t* pooled) {
    int tid_ = threadIdx.x; asm volatile("" : "+v"(tid_));
    const int lane = tid_ & 63, wave = __builtin_amdgcn_readfirstlane(tid_ >> 6);
    const int g = wave & 3, ch0 = g * 128 + (lane & 15) * 8, tsub = (wave >> 2) * 32 + (lane >> 4) * 8;
    for (int chunk = blockIdx.x; chunk < S / 64; chunk += gridDim.x) {
        const int t0 = chunk * 64 + tsub;
        if (g == 0) pool_tile<2>(xp, pooled, t0, ch0); else if (g == 1) pool_tile<4>(xp, pooled, t0, ch0); else if (g == 2) pool_tile<8>(xp, pooled, t0, ch0); else pool_tile<16>(xp, pooled, t0, ch0);
    }
}

constexpr int AT_ROWB = 144, AT_K2 = 64 * AT_ROWB, AT_KST = 2 * AT_K2  , AT_VST = 128 * AT_ROWB  , AT_VOFF = 2 * AT_KST;
#define MFMA32(a, b, c) __builtin_amdgcn_mfma_f32_32x32x16_bf16((a), (b), (c), 0, 0, 0)

__device__ __forceinline__ float at_max3(float a, float b, float c) { float r; asm("v_max3_f32 %0, %1, %2, %3" : "=v"(r) : "v"(a), "v"(b), "v"(c)); return r; }
__device__ __forceinline__ void at_qk_half(const bool ONLINE, const bool act, const LAS unsigned char* kp, u32x4& pfa, u32x4& pfb, const char* pga, const char* pgb, const bf16x8 (&qf)[4], int q, int q0, int kbase, int hh, float& mrun, f32x16 (&O)[4], f32x16& L, bf16x8 (&pf)[4]) {
    __builtin_amdgcn_s_setprio(3);
    bf16x8 kf[8];
#pragma unroll
    for (int s = 0; s < 4; ++s) { kf[2 * s] = *(const LAS bf16x8*)(kp + 32 * s); kf[2 * s + 1] = *(const LAS bf16x8*)(kp + 32 * AT_ROWB + 32 * s); }
    __builtin_amdgcn_sched_barrier(0);
    pfa = *(const u32x4*)pga; pfb = *(const u32x4*)pgb;
    __builtin_amdgcn_sched_barrier(0);
    if (!act) { __builtin_amdgcn_s_setprio(0); return; }
    f32x16 s0, s1;
#pragma unroll
    for (int i = 0; i < 16; ++i) { s0[i] = 0.f; s1[i] = 0.f; }
#pragma unroll
    for (int s = 0; s < 4; ++s) { s0 = MFMA32(kf[2 * s], qf[s], s0); s1 = MFMA32(kf[2 * s + 1], qf[s], s1); }
    __builtin_amdgcn_s_setprio(0);
    if (kbase + 63 > q0) {
        const int kb = kbase + 4 * hh;
#pragma unroll
        for (int i = 0; i < 16; ++i) { const int kv = kb + (i & 3) + 8 * (i >> 2); if (kv > q) s0[i] = -INFINITY; if (kv + 32 > q) s1[i] = -INFINITY; }
    }
    if (ONLINE) {
#pragma unroll
        for (int i = 0; i < 16; ++i) { s0[i] -= mrun; s1[i] -= mrun; }
        float mx = fmaxf(s0[0], s1[0]);
#pragma unroll
        for (int i = 1; i < 16; ++i) mx = at_max3(mx, s0[i], s1[i]);
        mx = half_swap_max(mx);
        if (__builtin_amdgcn_ballot_w64(mx > 8.f) != 0ull) {
            const float d = fmaxf(mx, 0.f); const float alpha = __builtin_amdgcn_exp2f(-d); mrun += d;
#pragma unroll
            for (int e = 0; e < 4; ++e)
#pragma unroll
                for (int i = 0; i < 16; ++i) O[e][i] *= alpha;
#pragma unroll
            for (int i = 0; i < 16; ++i) { L[i] *= alpha; s0[i] -= d; s1[i] -= d; }
        }
    }
#pragma unroll
    for (int i = 0; i < 16; ++i) { s0[i] = __builtin_amdgcn_exp2f(s0[i]); s1[i] = __builtin_amdgcn_exp2f(s1[i]); }
#pragma unroll
    for (int s2 = 0; s2 < 2; ++s2) {
        u32x4 a, b;
        a.x = pk2(s0[8 * s2 + 0], s0[8 * s2 + 1]); a.y = pk2(s0[8 * s2 + 2], s0[8 * s2 + 3]); a.z = pk2(s0[8 * s2 + 4], s0[8 * s2 + 5]); a.w = pk2(s0[8 * s2 + 6], s0[8 * s2 + 7]);
        b.x = pk2(s1[8 * s2 + 0], s1[8 * s2 + 1]); b.y = pk2(s1[8 * s2 + 2], s1[8 * s2 + 3]); b.z = pk2(s1[8 * s2 + 4], s1[8 * s2 + 5]); b.w = pk2(s1[8 * s2 + 6], s1[8 * s2 + 7]);
        pf[s2] = __builtin_bit_cast(bf16x8, a); pf[2 + s2] = __builtin_bit_cast(bf16x8, b);
    }
    __builtin_amdgcn_s_setprio(0);
}
__device__ __forceinline__ void at_pv_half(const LAS unsigned char* vp, const bf16x8 (&pf)[4], f32x16 (&O)[4], f32x16& L) {
    bf16x8 va[8], vb[8];
#pragma unroll
    for (int e = 0; e < 2; ++e)
#pragma unroll
        for (int ks = 0; ks < 4; ++ks) va[e * 4 + ks] = *(const LAS bf16x8*)(vp + e * 32 * AT_ROWB + 32 * ks);
#pragma unroll
    for (int e = 0; e < 2; ++e)
#pragma unroll
        for (int ks = 0; ks < 4; ++ks) vb[e * 4 + ks] = *(const LAS bf16x8*)(vp + (2 + e) * 32 * AT_ROWB + 32 * ks);
    const short one = (short)0x3F80; const bf16x8 ones = {one, one, one, one, one, one, one, one};
    __builtin_amdgcn_sched_barrier(0);
    __builtin_amdgcn_s_setprio(1);
#pragma unroll
    for (int ks = 0; ks < 4; ++ks) L = MFMA32(ones, pf[ks], L);
    __builtin_amdgcn_sched_barrier(0);
#pragma unroll
    for (int ks = 0; ks < 4; ++ks) { O[0] = MFMA32(va[ks], pf[ks], O[0]); O[1] = MFMA32(va[4 + ks], pf[ks], O[1]); }
#pragma unroll
    for (int ks = 0; ks < 4; ++ks) { O[2] = MFMA32(vb[ks], pf[ks], O[2]); O[3] = MFMA32(vb[4 + ks], pf[ks], O[3]); }
    __builtin_amdgcn_s_setprio(0);
}

__device__ __forceinline__ void attn_item(LAS unsigned char* lds, const bf16_t* Q, const bf16_t* Kb, const bf16_t* VT, bf16_t* aout, const float* subg, float lam, float omli, float kbound, int head, int qb) {
    int tid_ = threadIdx.x; asm volatile("" : "+v"(tid_));
    const int tid = tid_, lane = tid & 63, r = lane & 31, hh = lane >> 5; const int wid = __builtin_amdgcn_readfirstlane(tid >> 6);
    const int comp = wid >> 2, qt = wid & 3; const int q0 = qb * 128 + qt * 32, q = q0 + r; const int nt = 2 * qb + 2;
    bf16x8 qf[4];
    { const bf16_t* Qp = Q + ((size_t)(head * 2 + comp) * S + q) * 64 + 8 * hh;
#pragma unroll
      for (int s = 0; s < 4; ++s) qf[s] = *(const bf16x8*)(Qp + 16 * s); }
    const int srow = tid >> 3, sch = tid & 7;
    const char* bK1 = (const char*)(Kb + (size_t)(head * 2 + 0) * S * 64); const char* bK2 = (const char*)(Kb + (size_t)(head * 2 + 1) * S * 64);
    const char* bV0 = (const char*)(VT + (size_t)head * 256 * 128 * 64); const char* bV1 = bV0 + 8192;
    const unsigned koff = srow * 128 + sch * 16, voff = koff;
    const unsigned dK1 = srow * AT_ROWB + sch * 16, dK2 = AT_K2 + dK1, dV0 = AT_VOFF + dK1, dV1 = AT_VOFF + 64 * AT_ROWB + dK1;
    u32x4 ks0 = *(const u32x4*)(bK1 + koff), ks1 = *(const u32x4*)(bK2 + koff), vs0 = *(const u32x4*)(bV0 + voff), vs1 = *(const u32x4*)(bV1 + voff);
    *(LAS u32x4*)(lds + dK1) = ks0; *(LAS u32x4*)(lds + dK2) = ks1; *(LAS u32x4*)(lds + dV0) = vs0; *(LAS u32x4*)(lds + dV1) = vs1;
    ks0 = *(const u32x4*)(bK1 + 8192 + koff); ks1 = *(const u32x4*)(bK2 + 8192 + koff);
    asm volatile("" : "+v"(qf[0]), "+v"(qf[1]), "+v"(qf[2]), "+v"(qf[3]));
    __syncthreads();
    f32x16 O[4];
#pragma unroll
    for (int e = 0; e < 4; ++e)
#pragma unroll
        for (int i = 0; i < 16; ++i) O[e][i] = 0.f;
    float qn2 = 0.f;
#pragma unroll
    for (int s = 0; s < 4; ++s)
#pragma unroll
        for (int e = 0; e < 8; ++e) { const float v = bf2f((bf16_t)qf[s][e]); qn2 += v * v; }
    const float sbound = __builtin_sqrtf(half_swap_sum(qn2)) * kbound;
    const bool online = __builtin_amdgcn_ballot_w64(!(sbound <= 100.f)) != 0ull;
    float mrun = 0.f;
    f32x16 L;
#pragma unroll
    for (int i = 0; i < 16; ++i) L[i] = 0.f;
    bf16x8 pf[4];
#pragma unroll
    for (int i = 0; i < 4; ++i) pf[i] = (bf16x8){0, 0, 0, 0, 0, 0, 0, 0};
    const unsigned kfo = comp * AT_K2 + r * AT_ROWB + 16 * hh, vfo = AT_VOFF + r * AT_ROWB + 16 * hh;
    const int qmax = q0 + 31, ntm1 = nt - 1;
#define AT_ISSUE_V(jn) do { const int jc_ = (jn) < ntm1 ? (jn) : ntm1; const size_t vo_ = (size_t)jc_ * 16384; vs0 = *(const u32x4*)(bV0 + vo_ + voff); vs1 = *(const u32x4*)(bV1 + vo_ + voff); } while (0)
#define AT_ISSUE_K(jn) do { const int jc_ = (jn) < ntm1 ? (jn) : ntm1; const size_t ko_ = (size_t)jc_ * 8192; ks0 = *(const u32x4*)(bK1 + ko_ + koff); ks1 = *(const u32x4*)(bK2 + ko_ + koff); } while (0)
#define AT_WRITE_K(jn) do { LAS unsigned char* n_ = lds + ((jn) & 1) * AT_KST; *(LAS u32x4*)(n_ + dK1) = ks0; *(LAS u32x4*)(n_ + dK2) = ks1; } while (0)
#define AT_WRITE_V(jn) do { LAS unsigned char* n_ = lds + ((jn) & 1) * AT_KST; *(LAS u32x4*)(n_ + dV0) = vs0; *(LAS u32x4*)(n_ + dV1) = vs1; } while (0)
    if (comp == 0) {
        for (int j = 0; j < nt; ++j) {
            const LAS unsigned char* stg = lds + (j & 1) * AT_KST; const int kbase = j * 64; const bool act = kbase <= qmax;
            __builtin_amdgcn_s_setprio(3);
            { const int jc_ = (j + 1) < ntm1 ? (j + 1) : ntm1; const size_t vo_ = (size_t)jc_ * 16384; const char* pga = bV0 + vo_ + voff; const char* pgb = bV1 + vo_ + voff;
              at_qk_half(online, act, stg + kfo, vs0, vs1, pga, pgb, qf, q, q0, kbase, hh, mrun, O, L, pf); }
            __builtin_amdgcn_s_setprio(3);
            AT_WRITE_K(j + 1);
            __syncthreads();
            __builtin_amdgcn_s_setprio(0);
            AT_ISSUE_K(j + 2);
            if (act) at_pv_half(stg + vfo, pf, O, L);
            AT_WRITE_V(j + 1);
            __syncthreads();
        }
        __syncthreads();
    } else {
        for (int j = 0; j < nt; ++j) {
            const LAS unsigned char* stg = lds + (j & 1) * AT_KST; const LAS unsigned char* pst = lds + ((j + 1) & 1) * AT_KST; const int kbase = j * 64;
            AT_ISSUE_V(j + 1);
            if (j > 0 && kbase - 64 <= qmax) at_pv_half(pst + vfo, pf, O, L);
            AT_WRITE_K(j + 1);
            __syncthreads();
            __builtin_amdgcn_s_setprio(3);
            { const int jc_ = (j + 2) < ntm1 ? (j + 2) : ntm1; const size_t ko_ = (size_t)jc_ * 8192; const char* pga = bK1 + ko_ + koff; const char* pgb = bK2 + ko_ + koff;
              at_qk_half(online, kbase <= qmax, stg + kfo, ks0, ks1, pga, pgb, qf, q, q0, kbase, hh, mrun, O, L, pf); }
            __builtin_amdgcn_s_setprio(3);
            AT_WRITE_V(j + 1);
            __syncthreads();
            __builtin_amdgcn_s_setprio(0);
        }
        if ((nt - 1) * 64 <= qmax) at_pv_half(lds + ((nt - 1) & 1) * AT_KST + vfo, pf, O, L);
        __syncthreads();
    }
#undef AT_ISSUE_V
#undef AT_ISSUE_K
#undef AT_WRITE_K
#undef AT_WRITE_V
    const float inv = 1.f / L[0];
    LAS float* X = (LAS float*)lds;
    if (comp == 1) {
#pragma unroll
        for (int e = 0; e < 4; ++e)
#pragma unroll
            for (int i = 0; i < 16; ++i) X[(qt * 128 + 32 * e + (i & 3) + 8 * (i >> 2) + 4 * hh) * 32 + r] = O[e][i] * inv;
    }
    __syncthreads();
    if (comp == 0) {
        float ss = 0.f;
#pragma unroll
        for (int e = 0; e < 4; ++e)
#pragma unroll
            for (int i = 0; i < 16; ++i) { const float o = O[e][i] * inv - lam * X[(qt * 128 + 32 * e + (i & 3) + 8 * (i >> 2) + 4 * hh) * 32 + r]; O[e][i] = o; ss += o * o; }
        ss = half_swap_sum(ss);
        const float rn = __builtin_amdgcn_rsqf(ss * (1.f / 128.f) + EPS) * omli;
        bf16_t* ap = aout + (size_t)q * 1024 + head * 128 + 4 * hh;
#pragma unroll
        for (int e = 0; e < 4; ++e)
#pragma unroll
            for (int g4 = 0; g4 < 4; ++g4) { const int e0 = 32 * e + 8 * g4; const f32x4 sg = *(const f32x4*)(subg + e0 + 4 * hh);
                u32x2 w; w.x = pk2(O[e][4 * g4 + 0] * rn * sg[0], O[e][4 * g4 + 1] * rn * sg[1]); w.y = pk2(O[e][4 * g4 + 2] * rn * sg[2], O[e][4 * g4 + 3] * rn * sg[3]);
                *(u32x2*)(ap + e0) = w; }
    }
    __syncthreads();
}

__device__ __forceinline__ void attn_phase(LAS unsigned char* lds, const bf16_t* Q, const bf16_t* Kb, const bf16_t* VT, bf16_t* aout, const float* subg, const float* lp, const float* kgain, float lam_init) {
    int tid_ = threadIdx.x; asm volatile("" : "+v"(tid_));
    const int lane = tid_ & 63;
    const float d01 = wave_sum(lp[lane] * lp[64 + lane]), d23 = wave_sum(lp[128 + lane] * lp[192 + lane]);
    const float lam = __expf(d01) - __expf(d23) + lam_init, omli = 1.f - lam_init;
    float kg = fabsf(kgain[lane]);
#pragma unroll
    for (int o = 1; o < 64; o <<= 1) kg = fmaxf(kg, __shfl_xor(kg, o));
    const float kbound = 8.f * kg * 1.0079f;
    for (int it = blockIdx.x; it < 256; it += gridDim.x) {
        const int head = (it & 7) >> 1, pi = ((it >> 3) << 1) | (it & 1);
        attn_item(lds, Q, Kb, VT, aout, subg, lam, omli, kbound, head, 127 - pi);
        attn_item(lds, Q, Kb, VT, aout, subg, lam, omli, kbound, head, pi);
    }
}


#define XB_TMO      128
#define XB_XCNT(j)  (256  + 64 * (j))
#define XB_XSUB(j)  (1280 + 64 * (j))
#define XB_XGEN(j)  (2304 + 64 * (j))
#define XB_TOP      3328
#define XB_TOPGEN   3392
#define XCD_BAR_WORDS 3456
#define XB_SPIN_CAP (1u << 18)
__device__ __forceinline__ unsigned xb_ld(unsigned* p)              { return __hip_atomic_load(p, __ATOMIC_RELAXED, __HIP_MEMORY_SCOPE_AGENT); }
__device__ __forceinline__ unsigned xb_add(unsigned* p, unsigned v) { return __hip_atomic_fetch_add(p, v, __ATOMIC_RELAXED, __HIP_MEMORY_SCOPE_AGENT); }
__device__ __forceinline__ unsigned xb_xcc_id() { return (unsigned)__builtin_amdgcn_s_getreg((3 << 11) | 20) & 0xFu; }
#define XB_SPIN(cond, bar) do { unsigned _sp = 0; while (cond) { __builtin_amdgcn_s_sleep(1); \
    if ((++_sp & 255u) == 0u) { if (xb_ld(&(bar)[XB_TMO])) break; if (_sp > XB_SPIN_CAP) { atomicAdd(&(bar)[XB_TMO], 1u); break; } } } } while (0)
struct XcdBarrier { unsigned* bar; unsigned x; volatile LAS unsigned* st; };
__device__ __forceinline__ XcdBarrier xcd_barrier_post(unsigned* bar, volatile LAS unsigned* st) {
    XcdBarrier b; b.bar = bar; b.x = xb_xcc_id(); b.st = st;
    if (threadIdx.x == 0) (void)xb_add(&bar[XB_XCNT(b.x)], 1u);
    return b;
}
__device__ __forceinline__ void xcd_barrier_complete(unsigned* bar, unsigned x, unsigned& nloc, unsigned& nx) {
    const unsigned G = gridDim.x * gridDim.y * gridDim.z;
    unsigned sum, cnt, mine, sp = 0u;
    for (;;) {
        sum = 0u; cnt = 0u; mine = 0u;
#pragma unroll
        for (unsigned j = 0; j < 16; ++j) { const unsigned c = xb_ld(&bar[XB_XCNT(j)]); sum += c; cnt += (c > 0u) ? 1u : 0u; mine = (j == x) ? c : mine; }
        if (sum == G) break;
        __builtin_amdgcn_s_sleep(1);
        if ((++sp & 255u) == 0u) { if (xb_ld(&bar[XB_TMO])) break; if (sp > XB_SPIN_CAP) { atomicAdd(&bar[XB_TMO], 1u); break; } }
    }
    nloc = mine > 0u ? mine : 1u; nx = cnt > 0u ? cnt : 1u;
}
__device__ __forceinline__ void xcd_barrier(const XcdBarrier& b) {
    asm volatile("s_waitcnt vmcnt(0)" ::: "memory");
    __syncthreads();
    if (threadIdx.x == 0) {
        unsigned* bar = b.bar;
        __builtin_amdgcn_s_waitcnt(0);
        unsigned nloc = b.st[0], nx = b.st[1];
        if (nloc == 0u) { xcd_barrier_complete(bar, b.x, nloc, nx); b.st[0] = nloc; b.st[1] = nx; }
        const unsigned old = xb_add(&bar[XB_XSUB(b.x)], 1u);
        const unsigned gen = old / nloc;
        if (old + 1u == (gen + 1u) * nloc) {
            __builtin_amdgcn_fence(__ATOMIC_RELEASE, "agent");
            asm volatile("s_waitcnt vmcnt(0)" ::: "memory");
            const unsigned og = xb_add(&bar[XB_TOP], 1u);
            const unsigned tg = og / nx;
            if (og + 1u == (tg + 1u) * nx) xb_add(&bar[XB_TOPGEN], 1u);
            else XB_SPIN(xb_ld(&bar[XB_TOPGEN]) == tg, bar);
            __builtin_amdgcn_fence(__ATOMIC_ACQUIRE, "agent");
            xb_add(&bar[XB_XGEN(b.x)], 1u);
            asm volatile("s_waitcnt vmcnt(0)" ::: "memory");
        } else {
            XB_SPIN(xb_ld(&bar[XB_XGEN(b.x)]) == gen, bar);
            __builtin_amdgcn_fence(__ATOMIC_ACQUIRE, "agent");
            asm volatile("s_waitcnt vmcnt(0)" ::: "memory");
        }
    }
    __syncthreads();
}

__global__ void __launch_bounds__(512, 2) mk_fwd(Params p) {
    extern __shared__ __attribute__((aligned(16))) unsigned char lds_raw[];
    LAS unsigned char* lds = (LAS unsigned char*)lds_raw;
    cg::grid_group grid = cg::this_grid();
#define FRESH() int G = gridDim.x, bid = blockIdx.x; size_t wz_ = 0; asm volatile("" : "+s"(G), "+s"(bid), "+s"(wz_)); unsigned char* ws = p.ws + wz_
    XcdBarrier gbar;
    { FRESH(); (void)G;
      unsigned* barw = (unsigned*)(ws + WS_BAR);
      volatile LAS unsigned* bst = (volatile LAS unsigned*)(lds + 131072);
      if (threadIdx.x < 2) bst[threadIdx.x] = 0u;
      if (bid == 0) for (int i = threadIdx.x; i < XCD_BAR_WORDS; i += 512) barw[i] = 0u;
      gbar.bar = barw; gbar.x = 0; gbar.st = bst; }
#pragma unroll 1
    for (int l = 0; l < DEPTH; ++l) {
        const float lam_init = 0.8f - 0.6f * __expf(-0.3f * (float)l);
        prep_phase(p, l, lds);
        if (l == 0) { grid.sync(); gbar = xcd_barrier_post(gbar.bar, gbar.st); }
        else xcd_barrier(gbar);
        {
            FRESH(); float* ssq = (float*)(ws + WS_SSQ); bf16_t* xb = (bf16_t*)(ws + WS_XB);
            pg8::Gemm g{xb, (bf16_t*)(ws + WS_WIN), S, NIN, D}; pg8::StaticOrder So; So.init(S, NIN, G, bid);
            EpiInProj E{ssq, (bf16_t*)(ws + WS_Q), (bf16_t*)(ws + WS_K), (bf16_t*)(ws + WS_XP), (bf16_t*)(ws + WS_GATES), p.q_norm_g + l * 64, p.k_norm_g + l * 64, p.b_gate + l * 2048};
            pg8::gemm_phase<EpiInProj, pg8::StaticOrder, true, true>(lds, g, So, E);
            pg8::Gemm g2{(bf16_t*)(ws + WS_WV), xb, 512, S, D}; pg8::StaticOrder So2; So2.init(512, S, G, (bid + G / 2) % G);
            EpiVT E2{ssq, (bf16_t*)(ws + WS_VT)};
            pg8::gemm_phase<EpiVT, pg8::StaticOrder, true, true>(lds, g2, So2, E2);
        }
        xcd_barrier(gbar);
        {
            FRESH(); (void)G; (void)bid;
            pool_phase((const bf16_t*)(ws + WS_XP), (bf16_t*)(ws + WS_A));
            attn_phase(lds, (const bf16_t*)(ws + WS_Q), (const bf16_t*)(ws + WS_K), (const bf16_t*)(ws + WS_VT), (bf16_t*)(ws + WS_A), p.subln_g + l * 128, p.lam_params + l * 256, p.k_norm_g + l * 64, lam_init);
        }
        xcd_barrier(gbar);
        {
            FRESH(); pg8::StaticOrder So; So.init(S, D, G, bid);
            pg8::Gemm g{(bf16_t*)(ws + WS_A), (bf16_t*)(ws + WS_WUA), S, D, D}; EpiUp E{(const bf16_t*)(ws + WS_GATES), (bf16_t*)(ws + WS_MERGED)};
            pg8::gemm_phase<EpiUp, pg8::StaticOrder, true, true>(lds, g, So, E);
        }
        xcd_barrier(gbar);
        {
            FRESH(); pg8::StaticOrder So; So.init(S, D, G, bid);
            pg8::Gemm g{(bf16_t*)(ws + WS_MERGED), (bf16_t*)(ws + WS_WO), S, D, D};
            if (l == 0) { EpiResid<true, false> E{p.x, nullptr, (bf16_t*)(ws + WS_XB), (float*)(ws + WS_SSQ)}; pg8::gemm_phase<EpiResid<true, false>, pg8::StaticOrder, true, true>(lds, g, So, E); }
            else        { EpiResid<false, false> E{nullptr, nullptr, (bf16_t*)(ws + WS_XB), (float*)(ws + WS_SSQ)}; pg8::gemm_phase<EpiResid<false, false>, pg8::StaticOrder, true, true>(lds, g, So, E); }
        }
        xcd_barrier(gbar);
        {
            FRESH(); pg8::StaticOrder So; So.init(S, FF, G, bid);
            pg8::Gemm g{(bf16_t*)(ws + WS_XB), (bf16_t*)(ws + WS_W1), S, FF, D}; EpiMlpIn E{(float*)(ws + WS_SSQ), (bf16_t*)(ws + WS_U)};
            pg8::gemm_phase<EpiMlpIn, pg8::StaticOrder, true, true>(lds, g, So, E);
        }
        xcd_barrier(gbar);
        {
            FRESH(); pg8::StaticOrder So; So.init(S, D, G, bid);
            pg8::Gemm g{(bf16_t*)(ws + WS_U), (bf16_t*)(ws + WS_W2), S, D, FF};
            if (l + 1 < DEPTH) { EpiResid<false, false> E{nullptr, nullptr, (bf16_t*)(ws + WS_XB), (float*)(ws + WS_SSQ)}; pg8::gemm_phase<EpiResid<false, false>, pg8::StaticOrder, true, true>(lds, g, So, E); }
            else               { EpiResid<false, true> E{nullptr, p.out, (bf16_t*)(ws + WS_XB), nullptr}; pg8::gemm_phase<EpiResid<false, true>, pg8::StaticOrder, true, true>(lds, g, So, E); }
        }
        if (l + 1 < DEPTH) xcd_barrier(gbar);
    }
#undef FRESH
}

extern "C" void kernel_launch(void* const* d_in, const int* in_sizes, int n_in, void* d_out, int out_size, void* d_ws, size_t ws_size, hipStream_t stream) {
    static int grid_blocks = 0;
    if (grid_blocks == 0) {
        if (n_in != 16 || out_size != S * D || ws_size < WS_END) { fprintf(stderr, "kernel_launch: unexpected shapes (n_in %d, out %d, ws %zu)\n", n_in, out_size, ws_size); grid_blocks = -1; return; }
        int dev = 0, cus = 0, per_cu = 0;
        hipGetDevice(&dev); hipDeviceGetAttribute(&cus, hipDeviceAttributeMultiprocessorCount, dev);
        if (hipFuncSetAttribute((const void*)mk_fwd, hipFuncAttributeMaxDynamicSharedMemorySize, LDS_BYTES) != hipSuccess) { fprintf(stderr, "kernel_launch: hipFuncSetAttribute failed\n"); grid_blocks = -1; return; }
        if (hipOccupancyMaxActiveBlocksPerMultiprocessor(&per_cu, (const void*)mk_fwd, 512, LDS_BYTES) != hipSuccess || per_cu < 1) { fprintf(stderr, "kernel_launch: occupancy query says %d blocks per CU\n", per_cu); per_cu = 1; }
        (void)hipGetLastError();
        grid_blocks = cus;
    }
    if (grid_blocks < 0) return;
    Params p{};
    const float** pp = (const float**)&p;
    for (int i = 0; i < 16; ++i) pp[i] = (const float*)d_in[i];
    p.out = (float*)d_out; p.ws = (unsigned char*)d_ws;
    void* args[] = {&p};
    hipError_t e = hipLaunchCooperativeKernel((const void*)mk_fwd, dim3(grid_blocks), dim3(512), args, LDS_BYTES, stream);
    if (e != hipSuccess) fprintf(stderr, "cooperative launch failed: %s (grid %d)\n", hipGetErrorString(e), grid_blocks);
}
```
